# Optimizing an MI355X kernel written in HIP

```python
import jax, jax.numpy as jnp
from jax import lax
import numpy as np

D_MODEL = 1024
BATCH = 8
SEQ = 2048
DEPTH = 4

GRID_W = 64
CTX_LEN = 256
N_MIXERS = 2
GQA_HEADS = 16
GQA_KV_HEADS = 4
GQA_GROUP = GQA_HEADS // GQA_KV_HEADS
GQA_HEAD_DIM = D_MODEL // GQA_HEADS
MLA_HEADS = 16
MLA_Q_RANK = (3 * D_MODEL) // 8
MLA_KV_RANK = D_MODEL // 4
MLA_NOPE_DIM = 64
MLA_ROPE_DIM = 32
MLA_V_DIM = 64
FFN_HIDDEN = 4 * D_MODEL
ROPE_THETA = 10000.0
Q_BLOCK = 128
NORM_EPS = 1e-6
DEEPNORM_ALPHA = (2.0 * DEPTH) ** 0.25
DEEPNORM_BETA = (8.0 * DEPTH) ** -0.25

kernel_name = "hybrid_gqa_mla_deepnorm_dit"


def layer_norm(x, g, b):
    xf = x.astype(jnp.float32)
    mu = jnp.mean(xf, axis=-1, keepdims=True)
    var = jnp.mean(jnp.square(xf - mu), axis=-1, keepdims=True)
    return ((xf - mu) * lax.rsqrt(var + NORM_EPS) * g.astype(jnp.float32) + b.astype(jnp.float32)).astype(x.dtype)


def rms_norm(x, g):
    xf = x.astype(jnp.float32)
    ms = jnp.mean(jnp.square(xf), axis=-1, keepdims=True)
    return (xf * lax.rsqrt(ms + NORM_EPS) * g.astype(jnp.float32)).astype(x.dtype)


def grid_rope_tables(n_tok, rot_dim):
    rows = n_tok // GRID_W
    row = jnp.broadcast_to(jnp.arange(rows, dtype=jnp.float32)[:, None], (rows, GRID_W)).reshape(-1)
    col = jnp.broadcast_to(jnp.arange(GRID_W, dtype=jnp.float32)[None, :], (rows, GRID_W)).reshape(-1)
    axis_dim = rot_dim // 2
    inv_freq = ROPE_THETA ** (-jnp.arange(0, axis_dim, 2, dtype=jnp.float32) / axis_dim)
    ang_row = row[:, None] * inv_freq[None, :]
    ang_col = col[:, None] * inv_freq[None, :]
    return (jnp.cos(ang_row), jnp.sin(ang_row), jnp.cos(ang_col), jnp.sin(ang_col))


def rotate_axis(x, cos, sin):
    x1, x2 = jnp.split(x, 2, axis=-1)
    c = cos[:, None, :]
    s = sin[:, None, :]
    return jnp.concatenate([x1 * c - x2 * s, x2 * c + x1 * s], axis=-1)


def apply_grid_rope(x, tables):
    cr, sr, cc, sc = tables
    half = x.shape[-1] // 2
    xf = x.astype(jnp.float32)
    out = jnp.concatenate([rotate_axis(xf[..., :half], cr, sr), rotate_axis(xf[..., half:], cc, sc)], axis=-1)
    return out.astype(x.dtype)


def block_attention(q, k, v):
    b, sq, kvh, g, dk = q.shape
    nb = sq // Q_BLOCK
    scale = dk ** -0.5
    qb = jnp.moveaxis(q.reshape(b, nb, Q_BLOCK, kvh, g, dk), 1, 0)

    def one_block(qi):
        s = jnp.einsum('bqhgd,bkhd->bhgqk', qi, k, preferred_element_type=jnp.float32) * scale
        p = jax.nn.softmax(s, axis=-1).astype(v.dtype)
        return jnp.einsum('bhgqk,bkhe->bqhge', p, v)

    o = lax.map(one_block, qb)
    return jnp.moveaxis(o, 0, 1).reshape(b, sq, kvh * g * v.shape[-1])


def gqa_mixer(h_lat, h_ctx, w_qkv, q_norm, k_norm, w_o, rope, need_ctx):
    def project(h, rotate):
        b, n, _ = h.shape
        q, k, v = jnp.split(h @ w_qkv, [GQA_HEADS * GQA_HEAD_DIM, (GQA_HEADS + GQA_KV_HEADS) * GQA_HEAD_DIM], axis=-1)
        q = rms_norm(q.reshape(b, n, GQA_HEADS, GQA_HEAD_DIM), q_norm)
        k = rms_norm(k.reshape(b, n, GQA_KV_HEADS, GQA_HEAD_DIM), k_norm)
        v = v.reshape(b, n, GQA_KV_HEADS, GQA_HEAD_DIM)
        if rotate:
            q = apply_grid_rope(q, rope)
            k = apply_grid_rope(k, rope)
        return q.reshape(b, n, GQA_KV_HEADS, GQA_GROUP, GQA_HEAD_DIM), k, v

    q_lat, k_lat, v_lat = project(h_lat, True)
    q_ctx, k_ctx, v_ctx = project(h_ctx, False)
    k_all = jnp.concatenate([k_ctx, k_lat], axis=1)
    v_all = jnp.concatenate([v_ctx, v_lat], axis=1)
    y_lat = block_attention(q_lat, k_all, v_all) @ w_o
    y_ctx = block_attention(q_ctx, k_ctx, v_ctx) @ w_o if need_ctx else None
    return y_lat, y_ctx


def mla_mixer(h_lat, h_ctx, w_in, q_norm, kv_norm, w_uq, w_ukv, w_o, rope, need_ctx):
    def project(h, rotate):
        b, n, _ = h.shape
        cq, ckv, k_pe = jnp.split(h @ w_in, [MLA_Q_RANK, MLA_Q_RANK + MLA_KV_RANK], axis=-1)
        q = (rms_norm(cq, q_norm) @ w_uq).reshape(b, n, MLA_HEADS, MLA_NOPE_DIM + MLA_ROPE_DIM)
        q_nope, q_pe = jnp.split(q, [MLA_NOPE_DIM], axis=-1)
        kv = (rms_norm(ckv, kv_norm) @ w_ukv).reshape(b, n, MLA_HEADS, MLA_NOPE_DIM + MLA_V_DIM)
        k_nope, v = jnp.split(kv, [MLA_NOPE_DIM], axis=-1)
        k_pe = k_pe[:, :, None, :]
        if rotate:
            q_pe = apply_grid_rope(q_pe, rope)
            k_pe = apply_grid_rope(k_pe, rope)
        q = jnp.concatenate([q_nope, q_pe], axis=-1)[:, :, :, None, :]
        k = jnp.concatenate([k_nope, jnp.broadcast_to(k_pe, (b, n, MLA_HEADS, MLA_ROPE_DIM))], axis=-1)
        return q, k, v

    q_lat, k_lat, v_lat = project(h_lat, True)
    q_ctx, k_ctx, v_ctx = project(h_ctx, False)
    k_all = jnp.concatenate([k_ctx, k_lat], axis=1)
    v_all = jnp.concatenate([v_ctx, v_lat], axis=1)
    y_lat = block_attention(q_lat, k_all, v_all) @ w_o
    y_ctx = block_attention(q_ctx, k_ctx, v_ctx) @ w_o if need_ctx else None
    return y_lat, y_ctx


def sq_relu_mlp(h, w1, w2):
    return jnp.square(jax.nn.relu(h @ w1)) @ w2


def setup_inputs(seed: int = 0) -> dict:
    key = jax.random.key(seed)
    ks = jax.random.split(key, 20)
    d = D_MODEL
    n_a = (DEPTH + N_MIXERS - 1) // N_MIXERS
    n_b = DEPTH // N_MIXERS

    def w(k, shape, fan_in, gain=1.0):
        return jax.random.normal(k, shape, jnp.float32) * (gain * fan_in ** -0.5)

    def gain_vec(k, shape):
        return 1.0 + 0.02 * jax.random.normal(k, shape, jnp.float32)

    qkv_cols = (GQA_HEADS + 2 * GQA_KV_HEADS) * GQA_HEAD_DIM
    mla_in_cols = MLA_Q_RANK + MLA_KV_RANK + MLA_ROPE_DIM
    return {
        "x": jax.random.normal(ks[0], (BATCH, SEQ, d), jnp.float32),
        "c": jax.random.normal(ks[1], (BATCH, d), jnp.float32),
        "ctx": jax.random.normal(ks[2], (BATCH, CTX_LEN, d), jnp.float32),
        "c_ctx": jax.random.normal(ks[3], (d,), jnp.float32),
        "w_ada": w(ks[4], (DEPTH, d, 6 * d), d),
        "b_ada": 0.02 * jax.random.normal(ks[5], (DEPTH, 6 * d), jnp.float32),
        "ln_g": gain_vec(ks[6], (DEPTH, 2, d)),
        "ln_b": 0.02 * jax.random.normal(ks[7], (DEPTH, 2, d), jnp.float32),
        "mlp_w1": w(ks[8], (DEPTH, d, FFN_HIDDEN), d),
        "mlp_w2": w(ks[9], (DEPTH, FFN_HIDDEN, d), FFN_HIDDEN, DEEPNORM_BETA),
        "gqa_w_qkv": w(ks[10], (n_a, d, qkv_cols), d),
        "gqa_q_norm": gain_vec(ks[11], (n_a, GQA_HEAD_DIM)),
        "gqa_k_norm": gain_vec(ks[12], (n_a, GQA_HEAD_DIM)),
        "gqa_w_o": w(ks[13], (n_a, GQA_HEADS * GQA_HEAD_DIM, d), GQA_HEADS * GQA_HEAD_DIM, DEEPNORM_BETA),
        "mla_w_in": w(ks[14], (n_b, d, mla_in_cols), d),
        "mla_q_norm": gain_vec(ks[15], (n_b, MLA_Q_RANK)),
        "mla_kv_norm": gain_vec(ks[16], (n_b, MLA_KV_RANK)),
        "mla_w_uq": w(ks[17], (n_b, MLA_Q_RANK, MLA_HEADS * (MLA_NOPE_DIM + MLA_ROPE_DIM)), MLA_Q_RANK),
        "mla_w_ukv": w(ks[18], (n_b, MLA_KV_RANK, MLA_HEADS * (MLA_NOPE_DIM + MLA_V_DIM)), MLA_KV_RANK),
        "mla_w_o": w(ks[19], (n_b, MLA_HEADS * MLA_V_DIM, d), MLA_HEADS * MLA_V_DIM, DEEPNORM_BETA),
    }


def reference(x, c, ctx, c_ctx, w_ada, b_ada, ln_g, ln_b, mlp_w1, mlp_w2,
              gqa_w_qkv, gqa_q_norm, gqa_k_norm, gqa_w_o,
              mla_w_in, mla_q_norm, mla_kv_norm, mla_w_uq, mla_w_ukv, mla_w_o):
    n_tok = x.shape[1]
    rope_gqa = grid_rope_tables(n_tok, GQA_HEAD_DIM)
    rope_mla = grid_rope_tables(n_tok, MLA_ROPE_DIM)
    alpha = DEEPNORM_ALPHA
    silu_c = jax.nn.silu(c)
    silu_cc = jax.nn.silu(c_ctx)
    xc = ctx
    for i in range(DEPTH):
        need_ctx = i < DEPTH - 1
        mod_lat = (silu_c @ w_ada[i] + b_ada[i])[:, None, :]
        mod_ctx = silu_cc @ w_ada[i] + b_ada[i]
        sh_a, sc_a, g_a, sh_m, sc_m, g_m = jnp.split(mod_lat, 6, axis=-1)
        csh_a, csc_a, cg_a, csh_m, csc_m, cg_m = jnp.split(mod_ctx, 6, axis=-1)

        h_lat = x * (1.0 + sc_a) + sh_a
        h_ctx = xc * (1.0 + csc_a) + csh_a
        j = i // N_MIXERS
        if i % N_MIXERS == 0:
            y_lat, y_ctx = gqa_mixer(h_lat, h_ctx, gqa_w_qkv[j], gqa_q_norm[j], gqa_k_norm[j],
                                     gqa_w_o[j], rope_gqa, need_ctx)
        else:
            y_lat, y_ctx = mla_mixer(h_lat, h_ctx, mla_w_in[j], mla_q_norm[j], mla_kv_norm[j],
                                     mla_w_uq[j], mla_w_ukv[j], mla_w_o[j], rope_mla, need_ctx)

        x = layer_norm(alpha * x + g_a * y_lat, ln_g[i, 0], ln_b[i, 0])
        x = layer_norm(alpha * x + g_m * sq_relu_mlp(x * (1.0 + sc_m) + sh_m, mlp_w1[i], mlp_w2[i]),
                       ln_g[i, 1], ln_b[i, 1])
        if need_ctx:
            xc = layer_norm(alpha * xc + cg_a * y_ctx, ln_g[i, 0], ln_b[i, 0])
            xc = layer_norm(alpha * xc + cg_m * sq_relu_mlp(xc * (1.0 + csc_m) + csh_m, mlp_w1[i], mlp_w2[i]),
                            ln_g[i, 1], ln_b[i, 1])
    return x
```

```cpp
#include <hip/hip_runtime.h>
#include <hip/hip_cooperative_groups.h>
#include <cstdio>
namespace cg = cooperative_groups;

#ifndef MK_SINGLE
#define MK_SINGLE 1
#endif

#define DI __device__ __forceinline__
#define LAS __attribute__((address_space(3)))
typedef unsigned short bf16_t;
typedef short bf16x8 __attribute__((ext_vector_type(8)));
typedef float f32x4 __attribute__((ext_vector_type(4)));
typedef float f32x2 __attribute__((ext_vector_type(2)));
typedef float f32x16 __attribute__((ext_vector_type(16)));
typedef unsigned u32x4 __attribute__((ext_vector_type(4)));
typedef unsigned u32x2 __attribute__((ext_vector_type(2)));
typedef __bf16 bf2_t __attribute__((ext_vector_type(2)));
typedef short s16x4 __attribute__((ext_vector_type(4)));

constexpr int TL = 16384, TC = 2048, TT = 18432, DM = 1024, NKEY = 2304;
constexpr float LN_EPS = 1e-6f;
constexpr float ALPHA = 1.681792830507429f;
constexpr int LDS_STAGE = 131072;
constexpr int LDS_ROPE = LDS_STAGE + 64;
constexpr int LDS_BYTES = LDS_ROPE + 8192 + 4096;

constexpr size_t al256(size_t x) { return (x + 255) & ~(size_t)255; }
constexpr size_t OFF_BAR = 0;
constexpr size_t BAR_BYTES = 16384;
constexpr size_t OFF_MOD = OFF_BAR + BAR_BYTES;
constexpr size_t OFF_ROPEG = OFF_MOD + al256((size_t)4 * 9 * 6144 * 4);
constexpr size_t OFF_ROPEM = OFF_ROPEG + al256(64 * 16 * 2 * 4);
constexpr size_t OFF_STATS = OFF_ROPEM + al256(64 * 8 * 2 * 4);
constexpr size_t OFF_SSQ = OFF_STATS + al256((size_t)TT * 2 * 4);
constexpr size_t OFF_Z = OFF_SSQ + al256((size_t)TT * 20 * 4);
constexpr size_t OFF_W1T = OFF_Z + al256((size_t)TT * 1024 * 2);
constexpr size_t OFF_W2T = OFF_W1T + al256((size_t)4 * 4096 * 1024 * 2);
constexpr size_t OFF_QKVT = OFF_W2T + al256((size_t)4 * 4096 * 1024 * 2);
constexpr size_t OFF_WOGT = OFF_QKVT + al256((size_t)2 * 1536 * 1024 * 2);
constexpr size_t OFF_WINT = OFF_WOGT + al256((size_t)2 * 1024 * 1024 * 2);
constexpr size_t OFF_WUQT = OFF_WINT + al256((size_t)2 * 768 * 1024 * 2);
constexpr size_t OFF_WUKVT = OFF_WUQT + al256((size_t)2 * 1536 * 384 * 2);
constexpr size_t OFF_WOMT = OFF_WUKVT + al256((size_t)2 * 2048 * 256 * 2);
constexpr size_t OFF_H = OFF_WOMT + al256((size_t)2 * 1024 * 1024 * 2);
constexpr size_t OFF_R1 = OFF_H + al256((size_t)TT * 1024 * 2);
constexpr size_t OFF_Q = OFF_R1;
constexpr size_t OFF_K = OFF_Q + al256((size_t)TT * 1536 * 2);
constexpr size_t OFF_KPE = OFF_K + al256((size_t)8 * 16 * NKEY * 64 * 2);
constexpr size_t OFF_VT = OFF_KPE + al256((size_t)8 * NKEY * 32 * 2);
constexpr size_t OFF_CQ = OFF_VT + al256((size_t)8 * 16 * 64 * NKEY * 2);
constexpr size_t OFF_CKV = OFF_CQ + al256((size_t)TT * 384 * 2);
constexpr size_t END_MIX = OFF_CKV + al256((size_t)TT * 256 * 2);
constexpr size_t OFF_U = OFF_R1;
constexpr size_t END_U = OFF_U + al256((size_t)TT * 4096 * 2);
constexpr size_t OFF_PART = END_MIX > END_U ? END_MIX : END_U;
constexpr size_t WS_NEED = OFF_PART + al256((size_t)8 * TC * 1024 * 2);
static_assert(WS_NEED <= (size_t)402653184, "workspace budget");
constexpr int NSPLIT_WO = 4, NSPLIT_M2 = 8;

struct Params { const float* in[20]; float* out; unsigned char* ws; };
#define GAS __attribute__((address_space(1)))
#define P_IN(i) ((const float*)(GAS const float*)(p.in[i]))
#define P_WSF(off) ((float*)(GAS float*)(p.ws + (off)))
#define P_WSB(off) ((bf16_t*)(GAS bf16_t*)(p.ws + (off)))
#define P_OUT ((float*)(GAS float*)(p.out))


DI unsigned pk_bf16(float lo, float hi) {
    f32x2 v = {lo, hi};
    bf2_t r = __builtin_convertvector(v, bf2_t);
    return __builtin_bit_cast(unsigned, r);
}
DI f32x4 unpk4(u32x2 v) { f32x4 r; r[0] = __builtin_bit_cast(float, v[0] << 16); r[1] = __builtin_bit_cast(float, v[0] & 0xffff0000u); r[2] = __builtin_bit_cast(float, v[1] << 16); r[3] = __builtin_bit_cast(float, v[1] & 0xffff0000u); return r; }
DI bf16_t to_bf16(float f) { return (bf16_t)(pk_bf16(f, 0.f) & 0xffffu); }
DI float shx(float v, int m, int lane) { return __builtin_bit_cast(float, __builtin_amdgcn_ds_bpermute((lane ^ m) << 2, __builtin_bit_cast(int, v))); }
DI float wave_sum(float v, int lane) {
#pragma unroll
    for (int o = 32; o >= 1; o >>= 1) v += shx(v, o, lane);
    return v;
}

DI int perm32(int rho) { const int n = rho >> 4, i = rho & 15; return 8 * (i >> 2) + 4 * n + (i & 3); }
DI int rope32(int rho) { const int n = rho >> 4, fq = (rho >> 2) & 3, j = rho & 3; return 16 * (fq >> 1) + 4 * (fq & 1) + 8 * n + j; }
enum { MODE_NAT = 0, MODE_P8 = 1, MODE_GQA = 2, MODE_WIN = 3, MODE_UQ = 4, MODE_P8W = 5 };
DI int srccol(int mode, int nidx) {
    const int rho = nidx & 31;
    if (mode == MODE_NAT) return nidx;
    if (mode == MODE_P8) return (nidx & ~31) + perm32(rho);
    if (mode == MODE_P8W) { const int tc = nidx & 255, bj = tc >> 7, wc = (tc >> 5) & 3; return (nidx & ~255) + 64 * wc + 32 * bj + perm32(rho); }
    if (mode == MODE_GQA) {
        const int tile = nidx >> 8, tc = nidx & 255, bj = tc >> 7, wc = (tc >> 5) & 3, n = rho >> 4, fq = (rho >> 2) & 3, j = rho & 3;
        return 64 * (4 * tile + wc) + 32 * (fq >> 1) + 8 * (fq & 1) + 16 * bj + 4 * n + j;
    }
    if (mode == MODE_WIN) {
        if (nidx < 640) return (nidx & ~31) + perm32(rho);
        if (nidx < 672) return 640 + rope32(rho);
        return -1;
    }
    { const int part = (nidx >> 5) % 3; return (nidx & ~31) + (part == 2 ? rope32(rho) : perm32(rho)); }
}

DI void transpose_job(const int TID, const int BID, LAS unsigned char* lds, const float* W, int K, int Nsrc, int Npad, bf16_t* Bt, int mode, const float* kscale) {
    const int tid = TID;
    const int nkt = K >> 6, ntile = (Npad >> 6) * nkt;
    LAS unsigned* tl = (LAS unsigned*)lds;
    const int kp = tid >> 4, dq = tid & 15;
    for (int t = BID; t < ntile; t += gridDim.x) {
        const int n0 = (t / nkt) << 6, k0 = (t % nkt) << 6;
        const int sc = srccol(mode, n0 + 4 * dq);
        f32x4 va = {0.f, 0.f, 0.f, 0.f}, vb = va;
        if (sc >= 0) {
            va = *(const f32x4*)(W + (size_t)(k0 + 2 * kp) * Nsrc + sc); vb = *(const f32x4*)(W + (size_t)(k0 + 2 * kp + 1) * Nsrc + sc);
            if (kscale) { va *= kscale[k0 + 2 * kp]; vb *= kscale[k0 + 2 * kp + 1]; }
        }
#pragma unroll
        for (int e = 0; e < 4; ++e) tl[(4 * dq + e) * 33 + kp] = pk_bf16(va[e], vb[e]);
        __syncthreads();
        {
            const int n2 = tid >> 3, c2 = tid & 7;
            u32x4 o;
#pragma unroll
            for (int i = 0; i < 4; ++i) o[i] = tl[n2 * 33 + c2 * 4 + i];
            *(u32x4*)(Bt + (size_t)(n0 + n2) * K + k0 + c2 * 8) = o;
        }
        __syncthreads();
    }
}

DI void init_phase(const int TID, const int BID, LAS unsigned char* lds, const Params& p) {
    const int tid = TID;
    {
        const int i = BID * 512 + tid;
        if (i < 1024) { const int pos = i >> 4, f = i & 15; const float inv = powf(10000.f, -(float)f / 16.f); const float a = (float)pos * inv; P_WSF(OFF_ROPEG)[2 * i] = cosf(a); P_WSF(OFF_ROPEG)[2 * i + 1] = sinf(a); }
        else if (i < 1536) { const int i2 = i - 1024; const int pos = i2 >> 3, f = i2 & 7; const float inv = powf(10000.f, -(float)f / 8.f); const float a = (float)pos * inv; P_WSF(OFF_ROPEM)[2 * i2] = cosf(a); P_WSF(OFF_ROPEM)[2 * i2 + 1] = sinf(a); }
    }
    {
        LAS float* sl = (LAS float*)lds;
        LAS float* part = sl + 9216;
        for (int i = tid; i < 9216; i += 512) { const int j = i >> 10, k = i & 1023; const float cv = j < 8 ? P_IN(1)[j * 1024 + k] : P_IN(3)[k]; sl[i] = cv / (1.f + expf(-cv)); }
        __syncthreads();
        for (int item = BID; item < 384; item += gridDim.x) {
            const int l = item / 96, n0 = (item % 96) * 64, kg = tid >> 4, c4 = (tid & 15) * 4;
            const float* w = P_IN(4) + ((size_t)l * 1024 + kg * 32) * 6144 + n0 + c4;
            f32x4 acc9[9];
#pragma unroll
            for (int j = 0; j < 9; ++j) acc9[j] = (f32x4){0.f, 0.f, 0.f, 0.f};
#pragma unroll 8
            for (int k = 0; k < 32; ++k) {
                const f32x4 wv = *(const f32x4*)(w + (size_t)k * 6144);
                const LAS float* sp = sl + kg * 32 + k;
#pragma unroll
                for (int j = 0; j < 9; ++j) acc9[j] += wv * sp[j * 1024];
            }
#pragma unroll
            for (int j = 0; j < 9; ++j) *(LAS f32x4*)(part + (kg * 9 + j) * 64 + c4) = acc9[j];
            __syncthreads();
            for (int i = tid; i < 576; i += 512) {
                const int j = i >> 6, c2 = i & 63;
                float sum = 0.f;
#pragma unroll 8
                for (int g = 0; g < 32; ++g) sum += part[g * 576 + i];
                P_WSF(OFF_MOD)[(size_t)(l * 9 + j) * 6144 + n0 + c2] = sum + P_IN(5)[l * 6144 + n0 + c2];
            }
            __syncthreads();
        }
    }
    for (int l = 0; l < 4; ++l) transpose_job(TID, BID, lds, P_IN(8) + (size_t)l * 1024 * 4096, 1024, 4096, 4096, P_WSB(OFF_W1T) + (size_t)l * 4096 * 1024, MODE_P8W, nullptr);
    for (int l = 0; l < 4; ++l) transpose_job(TID, BID, lds, P_IN(9) + (size_t)l * 4096 * 1024, 4096, 1024, 1024, P_WSB(OFF_W2T) + (size_t)l * 1024 * 4096, MODE_P8, nullptr);
    for (int j = 0; j < 2; ++j) {
        transpose_job(TID, BID, lds, P_IN(10) + (size_t)j * 1024 * 1536, 1024, 1536, 1536, P_WSB(OFF_QKVT) + (size_t)j * 1536 * 1024, MODE_GQA, nullptr);
        transpose_job(TID, BID, lds, P_IN(13) + (size_t)j * 1024 * 1024, 1024, 1024, 1024, P_WSB(OFF_WOGT) + (size_t)j * 1024 * 1024, MODE_P8, nullptr);
        transpose_job(TID, BID, lds, P_IN(14) + (size_t)j * 1024 * 672, 1024, 672, 768, P_WSB(OFF_WINT) + (size_t)j * 768 * 1024, MODE_WIN, nullptr);
        transpose_job(TID, BID, lds, P_IN(17) + (size_t)j * 384 * 1536, 384, 1536, 1536, P_WSB(OFF_WUQT) + (size_t)j * 1536 * 384, MODE_UQ, P_IN(15) + j * 384);
        transpose_job(TID, BID, lds, P_IN(18) + (size_t)j * 256 * 2048, 256, 2048, 2048, P_WSB(OFF_WUKVT) + (size_t)j * 2048 * 256, MODE_P8, P_IN(16) + j * 256);
        transpose_job(TID, BID, lds, P_IN(19) + (size_t)j * 1024 * 1024, 1024, 1024, 1024, P_WSB(OFF_WOMT) + (size_t)j * 1024 * 1024, MODE_P8, nullptr);
    }
}

template <int PR>
#define PCOL(i) ((((i) >> 1) << 9) + lane * 8 + (((i) & 1) << 2))
DI void prep_rows(const int lane, const Params& p, int l, int which, int rbeg, int rend, int gw, int nw) {
    for (int row = rbeg + gw * PR; row < rend; row += nw * PR) {
        const int mi = row < TL ? (row >> 11) : 8;
        const bool raw = (which == 0 && l == 0);
        f32x4 v[PR][4];
#pragma unroll
        for (int rr = 0; rr < PR; ++rr) {
            const int r2 = row + rr;
            if (raw) {
                const float* src = r2 < TL ? P_IN(0) + (size_t)r2 * 1024 : P_IN(2) + (size_t)(r2 - TL) * 1024;
#pragma unroll
                for (int i = 0; i < 4; ++i) v[rr][i] = *(const f32x4*)(src + PCOL(i));
            } else {
                const bf16_t* src = P_WSB(OFF_Z) + (size_t)r2 * 1024;
#pragma unroll
                for (int i = 0; i < 4; i += 2) { const u32x4 zz = *(const u32x4*)(src + PCOL(i)); const u32x2 zl = {zz[0], zz[1]}, zh = {zz[2], zz[3]}; v[rr][i] = unpk4(zl); v[rr][i + 1] = unpk4(zh); }
            }
        }
        if (row >= TL && !raw) {
            const bool rawres = (which == 1 && l == 0);
            const int lp = which ? l : l - 1;
            const float* gp = P_WSF(OFF_MOD) + (size_t)(lp * 9 + 8) * 6144 + (which ? 2048 : 5120);
            if (rawres) {
#pragma unroll
                for (int rr = 0; rr < PR; ++rr) {
                    const float* cs = P_IN(2) + (size_t)(row + rr - TL) * 1024;
#pragma unroll
                    for (int i = 0; i < 4; ++i) v[rr][i] = *(const f32x4*)(cs + PCOL(i));
                }
            } else {
                const int lj = which ? (l * 2 - 1) : (l * 2 - 2);
                const float* lg2 = P_IN(6) + lj * 1024; const float* lb2 = P_IN(7) + lj * 1024;
#pragma unroll
                for (int i = 0; i < 4; ++i) {
                    const f32x4 g = *(const f32x4*)(lg2 + PCOL(i)), b = *(const f32x4*)(lb2 + PCOL(i));
#pragma unroll
                    for (int rr = 0; rr < PR; ++rr) { const f32x2 st = *(const f32x2*)(P_WSF(OFF_STATS) + 2 * (row + rr)); v[rr][i] = (v[rr][i] - st[0]) * st[1] * g + b; }
                }
            }
#pragma unroll
            for (int i = 0; i < 4; ++i) {
                const int c = PCOL(i);
                const f32x4 gv = *(const f32x4*)(gp + c);
#pragma unroll
                for (int rr = 0; rr < PR; ++rr) {
                    const bf16_t* pp = P_WSB(OFF_PART) + (size_t)(row + rr - TL) * 1024 + c;
                    f32x4 a = unpk4(*(const u32x2*)pp);
#pragma unroll
                    for (int k = 1; k < NSPLIT_WO; ++k) a += unpk4(*(const u32x2*)(pp + (size_t)k * TC * 1024));
                    if (which == 0) {
#pragma unroll
                        for (int k = NSPLIT_WO; k < NSPLIT_M2; ++k) a += unpk4(*(const u32x2*)(pp + (size_t)k * TC * 1024));
                    }
                    v[rr][i] = v[rr][i] * ALPHA + gv * a;
                    { u32x2 zo; zo[0] = pk_bf16(v[rr][i][0], v[rr][i][1]); zo[1] = pk_bf16(v[rr][i][2], v[rr][i][3]); *(u32x2*)(P_WSB(OFF_Z) + (size_t)(row + rr) * 1024 + c) = zo; v[rr][i] = unpk4(zo); }
                }
            }
        }
        if (!raw) {
            const int li = which == 2 ? 7 : (which ? (l * 2) : (l * 2 - 1));
            const float* lg = P_IN(6) + li * 1024; const float* lb = P_IN(7) + li * 1024;
            float sm[PR], sq[PR];
#pragma unroll
            for (int rr = 0; rr < PR; ++rr) { float s = 0.f;
#pragma unroll
                for (int i = 0; i < 4; ++i) s += v[rr][i][0] + v[rr][i][1] + v[rr][i][2] + v[rr][i][3];
                sm[rr] = s; }
#pragma unroll
            for (int o = 32; o >= 1; o >>= 1)
#pragma unroll
                for (int rr = 0; rr < PR; ++rr) sm[rr] += shx(sm[rr], o, lane);
#pragma unroll
            for (int rr = 0; rr < PR; ++rr) { const float mean = sm[rr] * (1.f / 1024.f); sm[rr] = mean; float q = 0.f;
#pragma unroll
                for (int i = 0; i < 4; ++i) { v[rr][i] -= mean; q += v[rr][i][0] * v[rr][i][0] + v[rr][i][1] * v[rr][i][1] + v[rr][i][2] * v[rr][i][2] + v[rr][i][3] * v[rr][i][3]; }
                sq[rr] = q; }
#pragma unroll
            for (int o = 32; o >= 1; o >>= 1)
#pragma unroll
                for (int rr = 0; rr < PR; ++rr) sq[rr] += shx(sq[rr], o, lane);
#pragma unroll
            for (int rr = 0; rr < PR; ++rr) { sq[rr] = rsqrtf(sq[rr] * (1.f / 1024.f) + LN_EPS);
                if (which != 2 && lane == 0) { P_WSF(OFF_STATS)[2 * (row + rr)] = sm[rr]; P_WSF(OFF_STATS)[2 * (row + rr) + 1] = sq[rr]; } }
#pragma unroll
            for (int i = 0; i < 4; ++i) { const f32x4 g = *(const f32x4*)(lg + PCOL(i)), b = *(const f32x4*)(lb + PCOL(i));
#pragma unroll
                for (int rr = 0; rr < PR; ++rr) v[rr][i] = v[rr][i] * sq[rr] * g + b; }
        }
        if (which == 2) {
#pragma unroll
            for (int rr = 0; rr < PR; ++rr)
#pragma unroll
                for (int i = 0; i < 4; ++i) *(f32x4*)(P_OUT + (size_t)(row + rr) * 1024 + PCOL(i)) = v[rr][i];
        } else {
            const float* modp = P_WSF(OFF_MOD) + (size_t)(l * 9 + mi) * 6144 + (which ? 3072 : 0);
#pragma unroll
            for (int i = 0; i < 4; i += 2) {
                const f32x4 sh0 = *(const f32x4*)(modp + PCOL(i)), sc0 = *(const f32x4*)(modp + 1024 + PCOL(i));
                const f32x4 sh1 = *(const f32x4*)(modp + PCOL(i + 1)), sc1 = *(const f32x4*)(modp + 1024 + PCOL(i + 1));
#pragma unroll
                for (int rr = 0; rr < PR; ++rr) {
                    const f32x4 h0 = v[rr][i] * (sc0 + 1.f) + sh0, h1 = v[rr][i + 1] * (sc1 + 1.f) + sh1;
                    u32x4 o; o[0] = pk_bf16(h0[0], h0[1]); o[1] = pk_bf16(h0[2], h0[3]); o[2] = pk_bf16(h1[0], h1[1]); o[3] = pk_bf16(h1[2], h1[3]);
                    *(u32x4*)(P_WSB(OFF_H) + (size_t)(row + rr) * 1024 + PCOL(i)) = o;
                }
            }
        }
    }
}
DI void prep_phase(const int TID, const int BID, const Params& p, int l, int which, int M) {
    if (M > TL) prep_rows<1>(TID & 63, p, l, which, TL, M, BID * 8 + (TID >> 6), gridDim.x * 8);
    prep_rows<4>(TID & 63, p, l, which, 0, TL, BID * 8 + (TID >> 6), gridDim.x * 8);
}
DI void final_phase(const int TID, const int BID, const Params& p) {
    prep_rows<4>(TID & 63, p, 3, 2, 0, TL, BID * 8 + (TID >> 6), gridDim.x * 8);
}

constexpr int BM = 256, BK = 64, HALF = 128, HTB = HALF * BK * 2, NXCD = 8, WGM = 8;
DI int lds_byte(int r, int c) { const int st = (r >> 4) * 2 + (c >> 5), rr = r & 15, cc = c & 31, ob = rr * 64 + cc * 2; return st * 1024 + (ob ^ (((ob >> 9) & 1) << 5)); }
DI void stage_rc(int b, int& R, int& C) { const int st = b / 1024, sb = b % 1024, swz = sb ^ (((sb >> 9) & 1) << 5); R = (st >> 1) * 16 + swz / 64; C = (st & 1) * 32 + (swz % 64) / 2; }
struct Unit { int pm, pn, k0, nt, ks; };
struct Gemm { const bf16_t* A; const bf16_t* Bt; int M, N, K; int nsplit; };
struct StaticOrder {
    int nM, nN, nwg, G, c, K, S;
    DI void init(int M, int N, int K_, int S_, int G_, int c_) { nM = M / BM; nN = N / BM; nwg = nM * nN; G = G_; c = c_; K = K_; S = S_; }
    DI bool next(int i, Unit& u) const {
        const long L = (long)i * G + c;
        u.pm = 0; u.pn = 0; u.k0 = 0; u.nt = K / BK; u.ks = -1;
        if (L >= nwg) {
            const int e = (int)(L - nwg);
            if (e >= 8 * nN * S) return false;
            const int tile = e / S;
            u.ks = e - tile * S; u.pm = TL / BM + (tile & 7); u.pn = tile >> 3; u.nt = K / (BK * S); u.k0 = u.ks * (K / S);
            return true;
        }
        int wgid = (int)L; { const int q = nwg / NXCD, r = nwg % NXCD, xcd = wgid % NXCD, off = wgid / NXCD; wgid = (xcd < r ? xcd * (q + 1) : r * (q + 1) + (xcd - r) * q) + off; }
        const int nig = WGM * nN, gid = wgid / nig, fm = gid * WGM, gsz = (nM - fm) < WGM ? (nM - fm) : WGM;
        u.pm = fm + ((wgid % nig) % gsz); u.pn = (wgid % nig) / gsz; u.k0 = 0; u.nt = K / BK; u.ks = -1; return true;
    }
};
template <class Epi>
DI void gemm_phase(const int TID, const int BID, LAS unsigned char* lds, const Gemm g, const Epi& E) {
    const int tid = TID, wid = __builtin_amdgcn_readfirstlane(tid >> 6), lane = tid & 63, wr = wid >> 2, wc = wid & 3, fr = lane & 15, fq = lane >> 4;
    int K = g.K; asm volatile("" : "+s"(K));
    StaticOrder S; S.init(g.M, g.N, K, g.nsplit, (int)gridDim.x, BID);
    unsigned voffA[2];
#pragma unroll
    for (int i = 0; i < 2; ++i) { int R, C; stage_rc(tid * 16 + i * 8192, R, C); voffA[i] = (unsigned)(R * K + C) * 2u; }
    const size_t kstep = (size_t)(BK * 2);
    const size_t hstep = (size_t)HALF * K * 2;
    const size_t tstep = 2 * hstep;
    const unsigned ldsw = (unsigned)wid * 1024u;
    const int aoff = lds_byte(wr * 64 + fr, fq * 8), boff = lds_byte(wc * 32 + fr, fq * 8);
#define PG8_SA(b, h) (((b) * 2 + (h)) * HTB)
#define PG8_SB(b, h) ((4 + (b) * 2 + (h)) * HTB)
#define PG8_STAGE(bufoff, gbase) do { _Pragma("unroll") for (int _i = 0; _i < 2; ++_i) \
        __builtin_amdgcn_global_load_lds((const unsigned*)((const char*)(gbase) + voffA[_i]), (LAS unsigned*)(lds + (bufoff) + ldsw + _i * 8192), 16, 0, 0); } while (0)
#define PG8_LDA(dst, b, h) do { _Pragma("unroll") for (int m = 0; m < 4; ++m) _Pragma("unroll") for (int k = 0; k < 2; ++k) dst[m][k] = *(const LAS bf16x8*)(lds + PG8_SA(b, h) + aoff + m * 2048 + k * 1024); } while (0)
#define PG8_LDB(dst, b, h) do { _Pragma("unroll") for (int n = 0; n < 2; ++n) _Pragma("unroll") for (int k = 0; k < 2; ++k) dst[n][k] = *(const LAS bf16x8*)(lds + PG8_SB(b, h) + boff + n * 2048 + k * 1024); } while (0)
#define PG8_MMA(ai, bj, At, Bt) do { __builtin_amdgcn_s_setprio(1); _Pragma("unroll") for (int m = 0; m < 4; ++m) _Pragma("unroll") for (int n = 0; n < 2; ++n) _Pragma("unroll") for (int k = 0; k < 2; ++k) \
        acc[ai][bj][m][n] = __builtin_amdgcn_mfma_f32_16x16x32_bf16(Bt[n][k], At[m][k], acc[ai][bj][m][n], 0, 0, 0); __builtin_amdgcn_s_setprio(0); } while (0)
#define PG8_WAIT_V(n) asm volatile("s_waitcnt vmcnt(" #n ")" ::: "memory")
#define PG8_WAIT_L(n) asm volatile("s_waitcnt lgkmcnt(" #n ")" ::: "memory")
#define PG8_BAR __builtin_amdgcn_s_barrier()
#define PG8_SCHED __builtin_amdgcn_sched_barrier(0)
    Unit cur, nxt; int ui = 0;
    if (!S.next(0, cur)) return;
    f32x4 acc[2][2][4][2];
#pragma unroll
    for (int a = 0; a < 2; ++a)
#pragma unroll
        for (int b = 0; b < 2; ++b)
#pragma unroll
            for (int m = 0; m < 4; ++m)
#pragma unroll
                for (int n = 0; n < 2; ++n) acc[a][b][m][n] = (f32x4){0.f, 0.f, 0.f, 0.f};
    bf16x8 At[4][2], B0[2][2], B1[2][2];
    const char* cA = (const char*)g.A + (size_t)cur.pm * tstep + (size_t)cur.k0 * 2; const char* cB = (const char*)g.Bt + (size_t)cur.pn * tstep + (size_t)cur.k0 * 2;
    PG8_STAGE(PG8_SB(0, 0), cB); PG8_STAGE(PG8_SA(0, 0), cA); PG8_STAGE(PG8_SB(0, 1), cB + hstep); PG8_STAGE(PG8_SA(0, 1), cA + hstep);
    if (wr == 1) PG8_BAR;
    PG8_WAIT_V(4); PG8_BAR;
    PG8_STAGE(PG8_SB(1, 0), cB + kstep); PG8_STAGE(PG8_SA(1, 0), cA + kstep); PG8_STAGE(PG8_SB(1, 1), cB + hstep + kstep);
    PG8_WAIT_V(6); PG8_BAR;
    for (;;) {
        const bool has_next = S.next(ui + 1, nxt);
        const char* nA = has_next ? (const char*)g.A + (size_t)nxt.pm * tstep + (size_t)nxt.k0 * 2 : cA; const char* nB = has_next ? (const char*)g.Bt + (size_t)nxt.pn * tstep + (size_t)nxt.k0 * 2 : cB;
        const int nt = cur.nt;
        for (int t = 0; t < nt; t += 2) {
            const bool last = (t == nt - 2);
            const char* a1 = cA + (size_t)(t + 1) * kstep;
            const char* a2 = last ? nA : cA + (size_t)(t + 2) * kstep; const char* b2 = last ? nB : cB + (size_t)(t + 2) * kstep;
            const char* a3 = a2 + kstep; const char* b3 = b2 + kstep;
            PG8_LDB(B0, 0, 0); PG8_SCHED; PG8_LDA(At, 0, 0); PG8_STAGE(PG8_SA(1, 1), a1 + hstep);
            PG8_WAIT_L(8); PG8_BAR; PG8_WAIT_L(0); PG8_MMA(0, 0, At, B0); PG8_BAR; PG8_SCHED;
            PG8_LDB(B1, 0, 1); PG8_STAGE(PG8_SB(0, 0), b2);
            PG8_BAR; PG8_WAIT_L(0); PG8_MMA(0, 1, At, B1); PG8_BAR;
            PG8_LDA(At, 0, 1); PG8_STAGE(PG8_SA(0, 0), a2);
            PG8_BAR; PG8_WAIT_L(0); PG8_MMA(1, 0, At, B0); PG8_BAR; PG8_SCHED;
            PG8_STAGE(PG8_SB(0, 1), b2 + hstep);
            PG8_WAIT_V(6); PG8_BAR; PG8_MMA(1, 1, At, B1); PG8_BAR;
            PG8_LDB(B0, 1, 0); PG8_SCHED; PG8_LDA(At, 1, 0); PG8_STAGE(PG8_SA(0, 1), a2 + hstep);
            PG8_WAIT_L(8); PG8_BAR; PG8_WAIT_L(0); PG8_MMA(0, 0, At, B0); PG8_BAR; PG8_SCHED;
            PG8_LDB(B1, 1, 1); PG8_STAGE(PG8_SB(1, 0), b3);
            PG8_BAR; PG8_WAIT_L(0); PG8_MMA(0, 1, At, B1); PG8_BAR;
            PG8_LDA(At, 1, 1); PG8_STAGE(PG8_SA(1, 0), a3);
            PG8_BAR; PG8_WAIT_L(0); PG8_MMA(1, 0, At, B0); PG8_BAR; PG8_SCHED;
            PG8_STAGE(PG8_SB(1, 1), b3 + hstep);
            PG8_WAIT_V(6); PG8_BAR; PG8_MMA(1, 1, At, B1); PG8_BAR;
        }
        E(acc, cur, wr, wc, fr, fq);
        if (!has_next) break;
#pragma unroll
        for (int a = 0; a < 2; ++a)
#pragma unroll
            for (int b = 0; b < 2; ++b)
#pragma unroll
                for (int m = 0; m < 4; ++m)
#pragma unroll
                    for (int n = 0; n < 2; ++n) acc[a][b][m][n] = (f32x4){0.f, 0.f, 0.f, 0.f};
        cur = nxt; cA = nA; cB = nB; ++ui;
    }
    PG8_WAIT_V(0);
    if (wr == 0) PG8_BAR;
    PG8_BAR;
#undef PG8_SA
#undef PG8_SB
#undef PG8_STAGE
#undef PG8_LDA
#undef PG8_LDB
#undef PG8_MMA
#undef PG8_WAIT_V
#undef PG8_WAIT_L
#undef PG8_BAR
#undef PG8_SCHED
}

typedef f32x4 Acc[2][2][4][2];

template <bool FIRST> struct EpiRes {
    bf16_t* z; const float* xin; const float* cin; const float* stats; const float* lng; const float* lnb; const float* gate; bf16_t* part;
    DI void operator()(const Acc& acc, const Unit& u, int wr, int wc, int fr, int fq) const {
        const int rowb = u.pm * BM, row0 = rowb + wr * 64 + fr, col0 = u.pn * BM + wc * 32 + 8 * fq;
        if (u.ks >= 0) {
            bf16_t* pb = part + ((size_t)u.ks * TC + (row0 - TL)) * 1024 + col0;
#pragma unroll
            for (int ai = 0; ai < 2; ++ai)
#pragma unroll
                for (int m = 0; m < 4; ++m)
#pragma unroll
                    for (int bj = 0; bj < 2; ++bj) {
                        const f32x4 a = acc[ai][bj][m][0], c = acc[ai][bj][m][1];
                        u32x4 o; o[0] = pk_bf16(a[0], a[1]); o[1] = pk_bf16(a[2], a[3]); o[2] = pk_bf16(c[0], c[1]); o[3] = pk_bf16(c[2], c[3]);
                        *(u32x4*)(pb + (size_t)(ai * HALF + m * 16) * 1024 + bj * HALF) = o;
                    }
            return;
        }
        const int mi = rowb < TL ? (rowb >> 11) : 8;
        const float* gp = gate + (size_t)mi * 6144;
        f32x2 st[2][4];
        if (!FIRST) {
#pragma unroll
            for (int ai = 0; ai < 2; ++ai)
#pragma unroll
                for (int m = 0; m < 4; ++m) st[ai][m] = *(const f32x2*)(stats + 2 * (row0 + ai * HALF + m * 16));
        }
#pragma unroll
        for (int bj = 0; bj < 2; ++bj) {
            const int c = col0 + bj * HALF;
            const f32x4 gv0 = *(const f32x4*)(gp + c), gv1 = *(const f32x4*)(gp + c + 4);
            f32x4 lg0 = {0.f, 0.f, 0.f, 0.f}, lg1 = lg0, lb0 = lg0, lb1 = lg0;
            if (!FIRST) { lg0 = *(const f32x4*)(lng + c); lg1 = *(const f32x4*)(lng + c + 4); lb0 = *(const f32x4*)(lnb + c); lb1 = *(const f32x4*)(lnb + c + 4); }
#pragma unroll
            for (int ai = 0; ai < 2; ++ai) {
                u32x4 zq[4]; f32x4 xa[4], xb[4];
#pragma unroll
                for (int m = 0; m < 4; ++m) {
                    const int r = row0 + ai * HALF + m * 16;
                    if (FIRST) { const float* src = r < TL ? xin + (size_t)r * 1024 : cin + (size_t)(r - TL) * 1024; xa[m] = *(const f32x4*)(src + c); xb[m] = *(const f32x4*)(src + c + 4); }
                    else zq[m] = *(const u32x4*)(z + (size_t)r * 1024 + c);
                }
                __builtin_amdgcn_sched_barrier(0);
#pragma unroll
                for (int m = 0; m < 4; ++m) {
                    const int r = row0 + ai * HALF + m * 16;
                    f32x4 y0, y1;
                    if (FIRST) { y0 = xa[m]; y1 = xb[m]; }
                    else { const u32x2 zl = {zq[m][0], zq[m][1]}, zh = {zq[m][2], zq[m][3]};
                           y0 = (unpk4(zl) - st[ai][m][0]) * st[ai][m][1] * lg0 + lb0; y1 = (unpk4(zh) - st[ai][m][0]) * st[ai][m][1] * lg1 + lb1; }
                    y0 = y0 * ALPHA + gv0 * acc[ai][bj][m][0]; y1 = y1 * ALPHA + gv1 * acc[ai][bj][m][1];
                    u32x4 o; o[0] = pk_bf16(y0[0], y0[1]); o[1] = pk_bf16(y0[2], y0[3]); o[2] = pk_bf16(y1[0], y1[1]); o[3] = pk_bf16(y1[2], y1[3]);
                    *(u32x4*)(z + (size_t)r * 1024 + c) = o;
                }
                __builtin_amdgcn_sched_barrier(0);
            }
        }
    }
};
struct EpiMlp1 {
    bf16_t* U;
    DI void operator()(const Acc& acc, const Unit& u, int wr, int wc, int fr, int fq) const {
        const int row0 = u.pm * BM + wr * 64 + fr, col0 = u.pn * BM + wc * 64 + 8 * fq;
#pragma unroll
        for (int ai = 0; ai < 2; ++ai)
#pragma unroll
            for (int m = 0; m < 4; ++m) {
                bf16_t* rp = U + (size_t)(row0 + ai * HALF + m * 16) * 4096 + col0;
#pragma unroll
                for (int bj = 0; bj < 2; ++bj) {
                    f32x4 a = acc[ai][bj][m][0], b = acc[ai][bj][m][1];
#pragma unroll
                    for (int j = 0; j < 4; ++j) { a[j] = a[j] > 0.f ? a[j] * a[j] : 0.f; b[j] = b[j] > 0.f ? b[j] * b[j] : 0.f; }
                    u32x4 o; o[0] = pk_bf16(a[0], a[1]); o[1] = pk_bf16(a[2], a[3]); o[2] = pk_bf16(b[0], b[1]); o[3] = pk_bf16(b[2], b[3]);
                    *(u32x4*)(rp + bj * 32) = o;
                }
            }
    }
};
struct EpiQkvG {
    bf16_t* Q; bf16_t* Kd; bf16_t* Vt; const float* qn; const float* kn; const LAS float* tab;
    DI void operator()(const Acc& acc, const Unit& u, int wr, int wc, int fr, int fq) const {
        const int rowb = u.pm * BM; const bool latent = rowb < TL;
        const int b = latent ? (rowb >> 11) : ((rowb - TL) >> 8);
        const int s0 = latent ? (rowb & 2047) : 0, kp0 = latent ? 256 + s0 : 0;
        const int tile = u.pn, dbase = 32 * (fq >> 1) + 8 * (fq & 1);
        if (tile <= 4) {
            const float* gn = tile < 4 ? qn : kn;
            f32x4 g[2][2];
#pragma unroll
            for (int bj = 0; bj < 2; ++bj)
#pragma unroll
                for (int n = 0; n < 2; ++n) g[bj][n] = *(const f32x4*)(gn + dbase + 16 * bj + 4 * n);
#pragma unroll
            for (int ai = 0; ai < 2; ++ai)
#pragma unroll
                for (int m = 0; m < 4; ++m) {
                    const int rl = ai * HALF + wr * 64 + m * 16 + fr, r = rowb + rl;
                    float ss = 0.f;
#pragma unroll
                    for (int bj = 0; bj < 2; ++bj)
#pragma unroll
                        for (int n = 0; n < 2; ++n) { const f32x4 a = acc[ai][bj][m][n]; ss += a[0] * a[0] + a[1] * a[1] + a[2] * a[2] + a[3] * a[3]; }
                    ss += shx(ss, 16, 16 * fq + fr); ss += shx(ss, 32, 16 * fq + fr);
                    const float rstd = rsqrtf(ss * (1.f / 64.f) + LN_EPS);
                    f32x4 v[2][2];
#pragma unroll
                    for (int bj = 0; bj < 2; ++bj)
#pragma unroll
                        for (int n = 0; n < 2; ++n) v[bj][n] = acc[ai][bj][m][n] * rstd * g[bj][n];
                    if (latent) {
                        const int s = s0 + rl, pos = (fq >> 1) ? (s & 63) : (s >> 6);
#pragma unroll
                        for (int n = 0; n < 2; ++n) {
                            const LAS float* tp = tab + (pos * 16 + 8 * (fq & 1) + 4 * n) * 2;
                            const f32x4 t0 = *(const LAS f32x4*)tp, t1 = *(const LAS f32x4*)(tp + 4);
                            const f32x4 cs = {t0[0], t0[2], t1[0], t1[2]}, sn = {t0[1], t0[3], t1[1], t1[3]};
                            const f32x4 x1 = v[0][n], x2 = v[1][n];
                            v[0][n] = x1 * cs - x2 * sn; v[1][n] = x2 * cs + x1 * sn;
                        }
                    }
#pragma unroll
                    for (int bj = 0; bj < 2; ++bj) {
                        u32x4 o; o[0] = pk_bf16(v[bj][0][0], v[bj][0][1]); o[1] = pk_bf16(v[bj][0][2], v[bj][0][3]); o[2] = pk_bf16(v[bj][1][0], v[bj][1][1]); o[3] = pk_bf16(v[bj][1][2], v[bj][1][3]);
                        bf16_t* dst = tile < 4 ? Q + (size_t)r * 1024 + (tile * 4 + wc) * 64 + dbase + 16 * bj
                                               : Kd + ((size_t)(b * 4 + wc) * NKEY + kp0 + rl) * 64 + dbase + 16 * bj;
                        *(u32x4*)dst = o;
                    }
                }
        } else {
#pragma unroll
            for (int ai = 0; ai < 2; ++ai)
#pragma unroll
                for (int m = 0; m < 4; ++m) {
                    const int rl = ai * HALF + wr * 64 + m * 16 + fr;
                    bf16_t* vb = Vt + ((size_t)(b * 4 + wc) * NKEY + kp0 + rl) * 64 + dbase;
#pragma unroll
                    for (int bj = 0; bj < 2; ++bj) {
                        const f32x4 a = acc[ai][bj][m][0], c = acc[ai][bj][m][1];
                        u32x4 o; o[0] = pk_bf16(a[0], a[1]); o[1] = pk_bf16(a[2], a[3]); o[2] = pk_bf16(c[0], c[1]); o[3] = pk_bf16(c[2], c[3]);
                        *(u32x4*)(vb + 16 * bj) = o;
                    }
                }
        }
    }
};
struct EpiWin {
    bf16_t* cq; bf16_t* ckv; bf16_t* kpe; float* ssq; const LAS float* tab;
    DI void operator()(const Acc& acc, const Unit& u, int wr, int wc, int fr, int fq) const {
        const int rowb = u.pm * BM; const bool latent = rowb < TL;
        const int b = latent ? (rowb >> 11) : ((rowb - TL) >> 8);
        const int s0 = latent ? (rowb & 2047) : 0, kp0 = latent ? 256 + s0 : 0;
#pragma unroll
        for (int bj = 0; bj < 2; ++bj) {
            const int L = u.pn * BM + bj * HALF + wc * 32;
            if (L < 640) {
#pragma unroll
                for (int ai = 0; ai < 2; ++ai)
#pragma unroll
                    for (int m = 0; m < 4; ++m) {
                        const int r = rowb + ai * HALF + wr * 64 + m * 16 + fr;
                        const f32x4 a = acc[ai][bj][m][0], c = acc[ai][bj][m][1];
                        float ss = a[0] * a[0] + a[1] * a[1] + a[2] * a[2] + a[3] * a[3] + c[0] * c[0] + c[1] * c[1] + c[2] * c[2] + c[3] * c[3];
                        ss += shx(ss, 16, 16 * fq + fr); ss += shx(ss, 32, 16 * fq + fr);
                        if (fq == 0) ssq[(size_t)r * 20 + (L >> 5)] = ss;
                        u32x4 o; o[0] = pk_bf16(a[0], a[1]); o[1] = pk_bf16(a[2], a[3]); o[2] = pk_bf16(c[0], c[1]); o[3] = pk_bf16(c[2], c[3]);
                        bf16_t* dst = L < 384 ? cq + (size_t)r * 384 + L + 8 * fq : ckv + (size_t)r * 256 + (L - 384) + 8 * fq;
                        *(u32x4*)dst = o;
                    }
            } else if (L == 640) {
#pragma unroll
                for (int ai = 0; ai < 2; ++ai)
#pragma unroll
                    for (int m = 0; m < 4; ++m) {
                        const int rl = ai * HALF + wr * 64 + m * 16 + fr;
                        f32x4 x1 = acc[ai][bj][m][0], x2 = acc[ai][bj][m][1];
                        if (latent) {
                            const int s = s0 + rl, pos = (fq >> 1) ? (s & 63) : (s >> 6);
                            const LAS float* tp = tab + (pos * 8 + 4 * (fq & 1)) * 2;
                            const f32x4 t0 = *(const LAS f32x4*)tp, t1 = *(const LAS f32x4*)(tp + 4);
                            const f32x4 cs = {t0[0], t0[2], t1[0], t1[2]}, sn = {t0[1], t0[3], t1[1], t1[3]};
                            const f32x4 y1 = x1 * cs - x2 * sn, y2 = x2 * cs + x1 * sn; x1 = y1; x2 = y2;
                        }
                        bf16_t* dst = kpe + ((size_t)b * NKEY + kp0 + rl) * 32 + 16 * (fq >> 1) + 4 * (fq & 1);
                        u32x2 o1, o2; o1[0] = pk_bf16(x1[0], x1[1]); o1[1] = pk_bf16(x1[2], x1[3]); o2[0] = pk_bf16(x2[0], x2[1]); o2[1] = pk_bf16(x2[2], x2[3]);
                        *(u32x2*)dst = o1; *(u32x2*)(dst + 8) = o2;
                    }
            }
        }
    }
};
struct EpiUq {
    bf16_t* Q; const float* ssq; const LAS float* tab;
    DI void operator()(const Acc& acc, const Unit& u, int wr, int wc, int fr, int fq) const {
        const int rowb = u.pm * BM; const bool latent = rowb < TL;
        const int s0 = latent ? (rowb & 2047) : 0;
        float rs[2][4];
        {
            f32x4 qv[2][4];
            const int slot = fq < 3 ? fq : 0;
#pragma unroll
            for (int ai = 0; ai < 2; ++ai)
#pragma unroll
                for (int m = 0; m < 4; ++m) qv[ai][m] = *(const f32x4*)(ssq + (size_t)(rowb + ai * HALF + wr * 64 + m * 16 + fr) * 20 + slot * 4);
#pragma unroll
            for (int ai = 0; ai < 2; ++ai)
#pragma unroll
                for (int m = 0; m < 4; ++m) {
                    float t = fq < 3 ? (qv[ai][m][0] + qv[ai][m][1]) + (qv[ai][m][2] + qv[ai][m][3]) : 0.f;
                    t += shx(t, 16, 16 * fq + fr); t += shx(t, 32, 16 * fq + fr);
                    rs[ai][m] = rsqrtf(t * (1.f / 384.f) + LN_EPS);
                }
            __builtin_amdgcn_sched_barrier(0);
        }
#pragma unroll
        for (int ai = 0; ai < 2; ++ai)
#pragma unroll
            for (int m = 0; m < 4; ++m) {
                const int rl = ai * HALF + wr * 64 + m * 16 + fr, r = rowb + rl;
                const float rstd = rs[ai][m];
#pragma unroll
                for (int bj = 0; bj < 2; ++bj) {
                    const int gidx = u.pn * 8 + bj * 4 + wc, head = gidx / 3, part = gidx - head * 3;
                    f32x4 x1 = acc[ai][bj][m][0] * rstd, x2 = acc[ai][bj][m][1] * rstd;
                    bf16_t* qrow = Q + (size_t)r * 1536 + head * 96;
                    if (part < 2) {
                        u32x4 o; o[0] = pk_bf16(x1[0], x1[1]); o[1] = pk_bf16(x1[2], x1[3]); o[2] = pk_bf16(x2[0], x2[1]); o[3] = pk_bf16(x2[2], x2[3]);
                        *(u32x4*)(qrow + part * 32 + 8 * fq) = o;
                    } else {
                        if (latent) {
                            const int s = s0 + rl, pos = (fq >> 1) ? (s & 63) : (s >> 6);
                            const LAS float* tp = tab + (pos * 8 + 4 * (fq & 1)) * 2;
                            const f32x4 t0 = *(const LAS f32x4*)tp, t1 = *(const LAS f32x4*)(tp + 4);
                            const f32x4 cs = {t0[0], t0[2], t1[0], t1[2]}, sn = {t0[1], t0[3], t1[1], t1[3]};
                            const f32x4 y1 = x1 * cs - x2 * sn, y2 = x2 * cs + x1 * sn; x1 = y1; x2 = y2;
                        }
                        bf16_t* dst = qrow + 64 + 16 * (fq >> 1) + 4 * (fq & 1);
                        u32x2 o1, o2; o1[0] = pk_bf16(x1[0], x1[1]); o1[1] = pk_bf16(x1[2], x1[3]); o2[0] = pk_bf16(x2[0], x2[1]); o2[1] = pk_bf16(x2[2], x2[3]);
                        *(u32x2*)dst = o1; *(u32x2*)(dst + 8) = o2;
                    }
                }
            }
    }
};
struct EpiUkv {
    bf16_t* Kd; bf16_t* Vt; const float* ssq;
    DI void operator()(const Acc& acc, const Unit& u, int wr, int wc, int fr, int fq) const {
        const int rowb = u.pm * BM; const bool latent = rowb < TL;
        const int b = latent ? (rowb >> 11) : ((rowb - TL) >> 8);
        const int kp0 = latent ? 256 + (rowb & 2047) : 0;
        float rs[2][4];
        {
            f32x4 qv[2][4];
            const int slot = fq < 2 ? fq : 0;
#pragma unroll
            for (int ai = 0; ai < 2; ++ai)
#pragma unroll
                for (int m = 0; m < 4; ++m) qv[ai][m] = *(const f32x4*)(ssq + (size_t)(rowb + ai * HALF + wr * 64 + m * 16 + fr) * 20 + 12 + slot * 4);
#pragma unroll
            for (int ai = 0; ai < 2; ++ai)
#pragma unroll
                for (int m = 0; m < 4; ++m) {
                    float t = fq < 2 ? (qv[ai][m][0] + qv[ai][m][1]) + (qv[ai][m][2] + qv[ai][m][3]) : 0.f;
                    t += shx(t, 16, 16 * fq + fr); t += shx(t, 32, 16 * fq + fr);
                    rs[ai][m] = rsqrtf(t * (1.f / 256.f) + LN_EPS);
                }
            __builtin_amdgcn_sched_barrier(0);
        }
#pragma unroll
        for (int ai = 0; ai < 2; ++ai)
#pragma unroll
            for (int m = 0; m < 4; ++m) {
                const int rl = ai * HALF + wr * 64 + m * 16 + fr, r = rowb + rl;
                const float rstd = rs[ai][m];
#pragma unroll
                for (int bj = 0; bj < 2; ++bj) {
                    const int head = u.pn * 2 + bj;
                    const f32x4 x1 = acc[ai][bj][m][0] * rstd, x2 = acc[ai][bj][m][1] * rstd;
                    if (wc < 2) {
                        u32x4 o; o[0] = pk_bf16(x1[0], x1[1]); o[1] = pk_bf16(x1[2], x1[3]); o[2] = pk_bf16(x2[0], x2[1]); o[3] = pk_bf16(x2[2], x2[3]);
                        *(u32x4*)(Kd + ((size_t)(b * 16 + head) * NKEY + kp0 + rl) * 64 + wc * 32 + 8 * fq) = o;
                    } else {
                        u32x4 o; o[0] = pk_bf16(x1[0], x1[1]); o[1] = pk_bf16(x1[2], x1[3]); o[2] = pk_bf16(x2[0], x2[1]); o[3] = pk_bf16(x2[2], x2[3]);
                        *(u32x4*)(Vt + ((size_t)(b * 16 + head) * NKEY + kp0 + rl) * 64 + (wc - 2) * 32 + 8 * fq) = o;
                    }
                }
            }
    }
};

DI float xmax32(float x) {
    const u32x2 r = __builtin_amdgcn_permlane32_swap(__builtin_bit_cast(unsigned, x), __builtin_bit_cast(unsigned, x), false, false);
    return fmaxf(__builtin_bit_cast(float, r[0]), __builtin_bit_cast(float, r[1]));
}
DI float xsum32(float x) {
    const u32x2 r = __builtin_amdgcn_permlane32_swap(__builtin_bit_cast(unsigned, x), __builtin_bit_cast(unsigned, x), false, false);
    return __builtin_bit_cast(float, r[0]) + __builtin_bit_cast(float, r[1]);
}
template <bool MLA>
DI void attn_phase(const int TID, const int BID, LAS unsigned char* lds, const Params& p, bool need_ctx) {
    constexpr int DK = MLA ? 96 : 64;
    constexpr int NKS = DK / 16;
    constexpr int KSTR = (DK + 8) * 2;
    constexpr int VSTR = 192;
    constexpr int KBUF = 64 * KSTR, VBUF = 64 * VSTR;
    constexpr int NKV = MLA ? 16 : 4;
    constexpr int QS = 16 * DK;
    const float sc = (MLA ? 0.10206207261596575f : 0.125f) * 1.4426950408889634f;
    const int tid = TID, wid = tid >> 6, lane = tid & 63, r = lane & 31, hh = lane >> 5;
    const int n_items = 1024 + (need_ctx ? 128 : 0);
    bf16_t* O = P_WSB(OFF_H);
    for (int item = BID; item < n_items; item += gridDim.x) {
        int b, head, row0, nk;
        if (item < 1024) {
            const int rnd = item >> 8, w = item & 255, xcd = w & 7, slot = w >> 3, qb = slot & 7;
            if (MLA) { const int grp = (rnd * 8 + xcd) * 4 + (slot >> 3); b = grp >> 4; head = grp & 15; }
            else { const int grp = rnd * 8 + xcd; b = grp >> 2; head = (grp & 3) * 4 + (slot >> 3); }
            row0 = b * 2048 + qb * 256; nk = NKEY;
        }
        else { const int it = item - 1024; b = it >> 4; head = it & 15; row0 = TL + b * 256; nk = 256; }
        const int kvh = MLA ? head : (head >> 2);
        const bf16_t* Kb = P_WSB(OFF_K) + (size_t)(b * NKV + kvh) * NKEY * 64;
        const bf16_t* Vb = P_WSB(OFF_VT) + (size_t)(b * NKV + kvh) * NKEY * 64;
        const bf16_t* Pb = P_WSB(OFF_KPE) + (size_t)b * NKEY * 32;
        bf16x8 qf[NKS];
        {
            const bf16_t* qp = P_WSB(OFF_Q) + (size_t)(row0 + wid * 32 + r) * QS + head * DK + hh * 8;
#pragma unroll
            for (int ks = 0; ks < NKS; ++ks) qf[ks] = *(const bf16x8*)(qp + ks * 16);
        }
        u32x4 kreg, vreg, preg = {0u, 0u, 0u, 0u};
#define AT_GLOADK(k0) do { kreg = *(const u32x4*)(Kb + (size_t)((k0) + (tid >> 3)) * 64 + (tid & 7) * 8); \
            if (MLA && tid < 256) preg = *(const u32x4*)(Pb + (size_t)((k0) + (tid >> 2)) * 32 + (tid & 3) * 8); } while (0)
#define AT_GLOADV(k0) do { vreg = *(const u32x4*)(Vb + (size_t)((k0) + (tid >> 3)) * 64 + (tid & 7) * 8); } while (0)
#define AT_WRITEK(buf) do { *(LAS u32x4*)(lds + (buf) * KBUF + (tid >> 3) * KSTR + (tid & 7) * 16) = kreg; \
            if (MLA && tid < 256) *(LAS u32x4*)(lds + (buf) * KBUF + (tid >> 2) * KSTR + 128 + (tid & 3) * 16) = preg; } while (0)
#define AT_WRITEV(buf) do { *(LAS u32x4*)(lds + 2 * KBUF + (buf) * VBUF + (tid >> 3) * VSTR + (tid & 7) * 16) = vreg; } while (0)
#define AT_QK(S0, S1, buf) do { const LAS unsigned char* kb = lds + (buf) * KBUF + r * KSTR + hh * 16; \
            _Pragma("unroll") for (int j = 0; j < 16; ++j) { S0[j] = 0.f; S1[j] = 0.f; } \
            _Pragma("unroll") for (int ks = 0; ks < NKS; ++ks) { \
                const bf16x8 a0 = *(const LAS bf16x8*)(kb + ks * 32); const bf16x8 a1 = *(const LAS bf16x8*)(kb + 32 * KSTR + ks * 32); \
                S0 = __builtin_amdgcn_mfma_f32_32x32x16_bf16(a0, qf[ks], S0, 0, 0, 0); S1 = __builtin_amdgcn_mfma_f32_32x32x16_bf16(a1, qf[ks], S1, 0, 0, 0); } } while (0)
#define AT_FMA(d, a_, b_, c_) do { float _a = (a_); asm("" : "+v"(_a)); d = __builtin_fmaf(_a, b_, c_); } while (0)
#define AT_ADD(d, a_, b_) do { d = (a_) + (b_); asm("" : "+v"(d)); } while (0)
#define AT_SMPV(S0, S1, buf) do { \
            float mx = fmaxf(fmaxf(S0[0], S0[1]), fmaxf(S1[0], S1[1])); \
            _Pragma("unroll") for (int j = 2; j < 16; j += 2) mx = fmaxf(mx, fmaxf(fmaxf(S0[j], S0[j + 1]), fmaxf(S1[j], S1[j + 1]))); \
            mx = xmax32(mx) * sc; \
            if (__builtin_amdgcn_ballot_w64(mx > mrun + 8.f) != 0ull) { \
                const float mnew = fmaxf(mrun, mx); const float alpha = __builtin_amdgcn_exp2f(mrun - mnew); mrun = mnew; lsum *= alpha; \
                _Pragma("unroll") for (int j = 0; j < 16; ++j) { o0[j] *= alpha; o1[j] *= alpha; } } \
            float psa = 0.f, psb = 0.f; const float nmr = -mrun; \
            _Pragma("unroll") for (int j = 0; j < 16; ++j) { \
                float e0, e1; AT_FMA(e0, S0[j], sc, nmr); AT_FMA(e1, S1[j], sc, nmr); \
                e0 = __builtin_amdgcn_exp2f(e0); e1 = __builtin_amdgcn_exp2f(e1); \
                AT_ADD(psa, psa, e0); AT_ADD(psb, psb, e1); S0[j] = e0; S1[j] = e1; } \
            lsum += psa + psb; \
            const LAS unsigned char* vb = lds + 2 * KBUF + (buf) * VBUF + (4 * hh + ((lane >> 2) & 3)) * VSTR + (16 * ((lane >> 4) & 1) + 4 * (lane & 3)) * 2; \
            _Pragma("unroll") for (int kt = 0; kt < 2; ++kt) _Pragma("unroll") for (int s = 0; s < 2; ++s) { \
                u32x4 pk; \
                if (kt == 0) { pk[0] = pk_bf16(S0[8 * s], S0[8 * s + 1]); pk[1] = pk_bf16(S0[8 * s + 2], S0[8 * s + 3]); pk[2] = pk_bf16(S0[8 * s + 4], S0[8 * s + 5]); pk[3] = pk_bf16(S0[8 * s + 6], S0[8 * s + 7]); } \
                else { pk[0] = pk_bf16(S1[8 * s], S1[8 * s + 1]); pk[1] = pk_bf16(S1[8 * s + 2], S1[8 * s + 3]); pk[2] = pk_bf16(S1[8 * s + 4], S1[8 * s + 5]); pk[3] = pk_bf16(S1[8 * s + 6], S1[8 * s + 7]); } \
                const bf16x8 pf = __builtin_bit_cast(bf16x8, pk); \
                const int koff = (kt * 32 + 16 * s) * VSTR; \
                const s16x4 l0 = __builtin_amdgcn_ds_read_tr16_b64_v4i16((LAS s16x4*)(vb + koff)), h0 = __builtin_amdgcn_ds_read_tr16_b64_v4i16((LAS s16x4*)(vb + koff + 8 * VSTR)); \
                const s16x4 l1 = __builtin_amdgcn_ds_read_tr16_b64_v4i16((LAS s16x4*)(vb + koff + 64)), h1 = __builtin_amdgcn_ds_read_tr16_b64_v4i16((LAS s16x4*)(vb + koff + 8 * VSTR + 64)); \
                const bf16x8 va0 = {l0[0], l0[1], l0[2], l0[3], h0[0], h0[1], h0[2], h0[3]}, va1 = {l1[0], l1[1], l1[2], l1[3], h1[0], h1[1], h1[2], h1[3]}; \
                o0 = __builtin_amdgcn_mfma_f32_32x32x16_bf16(va0, pf, o0, 0, 0, 0); \
                o1 = __builtin_amdgcn_mfma_f32_32x32x16_bf16(va1, pf, o1, 0, 0, 0); } } while (0)
#define AT_STEP(SC0, SC1, SN0, SN1, t, DOK, DOV) do { \
            if (DOK) AT_GLOADK(((t) + 2) * 64); \
            if (DOV) { AT_GLOADV(((t) + 1) * 64); AT_QK(SN0, SN1, ((t) + 1) & 1); } \
            AT_SMPV(SC0, SC1, (t) & 1); \
            if (DOK) AT_WRITEK((t) & 1); \
            if (DOV) AT_WRITEV(((t) + 1) & 1); \
            __syncthreads(); } while (0)
        f32x16 o0, o1, sa0, sa1, sb0, sb1;
#pragma unroll
        for (int j = 0; j < 16; ++j) { o0[j] = 0.f; o1[j] = 0.f; }
        float mrun = -1e30f, lsum = 0.f;
        if (wid >= 4) __builtin_amdgcn_s_setprio(1);
        const int ntile = nk >> 6;
        AT_GLOADK(0); AT_GLOADV(0); AT_WRITEK(0); AT_WRITEV(0);
        AT_GLOADK(64); AT_WRITEK(1);
        __syncthreads();
        AT_QK(sa0, sa1, 0);
        __syncthreads();
        int t = 0;
        for (; t < ntile - 2; t += 2) {
            AT_STEP(sa0, sa1, sb0, sb1, t, true, true);
            AT_STEP(sb0, sb1, sa0, sa1, t + 1, true, true);
        }
        AT_STEP(sa0, sa1, sb0, sb1, t, false, true);
        AT_STEP(sb0, sb1, sa0, sa1, t + 1, false, false);
        __builtin_amdgcn_s_setprio(0);
        lsum = xsum32(lsum);
        const float inv = 1.f / lsum;
        bf16_t* op = O + (size_t)(row0 + wid * 32 + r) * 1024 + head * 64 + 4 * hh;
#pragma unroll
        for (int jg = 0; jg < 4; ++jg) {
            u32x2 a, c;
            a[0] = pk_bf16(o0[4 * jg] * inv, o0[4 * jg + 1] * inv); a[1] = pk_bf16(o0[4 * jg + 2] * inv, o0[4 * jg + 3] * inv);
            c[0] = pk_bf16(o1[4 * jg] * inv, o1[4 * jg + 1] * inv); c[1] = pk_bf16(o1[4 * jg + 2] * inv, o1[4 * jg + 3] * inv);
            *(u32x2*)(op + 8 * jg) = a; *(u32x2*)(op + 32 + 8 * jg) = c;
        }
#undef AT_GLOADK
#undef AT_GLOADV
#undef AT_WRITEK
#undef AT_WRITEV
#undef AT_QK
#undef AT_SMPV
#undef AT_FMA
#undef AT_ADD
#undef AT_STEP
    }
}

#define XB_TMO      128
#define XB_XCNT(j)  (256  + 64 * (j))
#define XB_XSUB(j)  (1280 + 64 * (j))
#define XB_XGEN(j)  (2304 + 64 * (j))
#define XB_TOP      3328
#define XB_TOPGEN   3392
#define XCD_BAR_WORDS 3456
#define XB_SPIN_CAP (1u << 18)
DI unsigned xb_ld(unsigned* p)              { return __hip_atomic_load(p, __ATOMIC_RELAXED, __HIP_MEMORY_SCOPE_AGENT); }
DI unsigned xb_add(unsigned* p, unsigned v) { return __hip_atomic_fetch_add(p, v, __ATOMIC_RELAXED, __HIP_MEMORY_SCOPE_AGENT); }
DI unsigned xb_xcc_id() { return (unsigned)__builtin_amdgcn_s_getreg((3 << 11) | 20) & 0xFu; }
#define XB_SPIN(cond, bar) do { unsigned _sp = 0; while (cond) { __builtin_amdgcn_s_sleep(1); \
    if ((++_sp & 255u) == 0u) { if (xb_ld(&(bar)[XB_TMO])) break; if (_sp > XB_SPIN_CAP) { atomicAdd(&(bar)[XB_TMO], 1u); break; } } } } while (0)
DI void xcd_barrier_complete(unsigned* bar, unsigned x, unsigned& nloc, unsigned& nx) {
    const unsigned G = gridDim.x;
    unsigned sum, cnt, mine, sp = 0u;
    for (;;) {
        sum = 0u; cnt = 0u; mine = 0u;
#pragma unroll
        for (unsigned j = 0; j < 16; ++j) { const unsigned c = xb_ld(&bar[XB_XCNT(j)]); sum += c; cnt += (c > 0u) ? 1u : 0u; mine = (j == x) ? c : mine; }
        if (sum == G) break;
        __builtin_amdgcn_s_sleep(1);
        if ((++sp & 255u) == 0u) { if (xb_ld(&bar[XB_TMO])) break; if (sp > XB_SPIN_CAP) { atomicAdd(&bar[XB_TMO], 1u); break; } }
    }
    nloc = mine > 0u ? mine : 1u; nx = cnt > 0u ? cnt : 1u;
}
DI void xcd_barrier(unsigned* bar, volatile LAS unsigned* st, const int tid) {
    asm volatile("s_waitcnt vmcnt(0)" ::: "memory");
    __syncthreads();
    if (tid == 0) {
        const unsigned x = xb_xcc_id();
        __builtin_amdgcn_s_waitcnt(0);
        unsigned nloc = st[0], nx = st[1];
        if (nloc == 0u) { xcd_barrier_complete(bar, x, nloc, nx); st[0] = nloc; st[1] = nx; }
        const unsigned old = xb_add(&bar[XB_XSUB(x)], 1u);
        const unsigned gen = old / nloc;
        if (old + 1u == (gen + 1u) * nloc) {
            __builtin_amdgcn_fence(__ATOMIC_RELEASE, "agent");
            asm volatile("s_waitcnt vmcnt(0)" ::: "memory");
            const unsigned og = xb_add(&bar[XB_TOP], 1u);
            const unsigned tg = og / nx;
            if (og + 1u == (tg + 1u) * nx) xb_add(&bar[XB_TOPGEN], 1u);
            else XB_SPIN(xb_ld(&bar[XB_TOPGEN]) == tg, bar);
            __builtin_amdgcn_fence(__ATOMIC_ACQUIRE, "agent");
            xb_add(&bar[XB_XGEN(x)], 1u);
            asm volatile("s_waitcnt vmcnt(0)" ::: "memory");
        } else {
            XB_SPIN(xb_ld(&bar[XB_XGEN(x)]) == gen, bar);
            __builtin_amdgcn_fence(__ATOMIC_ACQUIRE, "agent");
            asm volatile("s_waitcnt vmcnt(0)" ::: "memory");
        }
    }
    __syncthreads();
}

constexpr int NPHASE = 34;
__host__ __device__ inline bool phase_empty(int ph) { if (ph == 0 || ph == NPHASE - 1) return false; const int l = (ph - 1) >> 3, s = (ph - 1) & 7; return s == 2 && (l & 1) == 0; }

DI void run_phase(const int TID, const int BID, LAS unsigned char* lds, const Params& p, int ph) {
    if (ph == 0) { init_phase(TID, BID, lds, p); return; }
    if (ph == NPHASE - 1) { final_phase(TID, BID, p); return; }
    const int l = (ph - 1) >> 3, s = (ph - 1) & 7, j = l >> 1;
    const bool mla = l & 1;
    const int Mres = (l == 3) ? TL : TT;
    const float* modl = P_WSF(OFF_MOD) + (size_t)l * 9 * 6144;
    const LAS float* ropeG_l = (const LAS float*)(lds + LDS_ROPE);
    const LAS float* ropeM_l = (const LAS float*)(lds + LDS_ROPE + 8192);
    if (s == 1 || s == 2) {
        for (int i = TID; i < 3072; i += 512) ((LAS float*)(lds + LDS_ROPE))[i] = i < 2048 ? P_WSF(OFF_ROPEG)[i] : P_WSF(OFF_ROPEM)[i - 2048];
        __syncthreads();
    }
    switch (s) {
    case 0: prep_phase(TID, BID, p, l, 0, TT); break;
    case 1:
        if (!mla) { Gemm g{P_WSB(OFF_H), P_WSB(OFF_QKVT) + (size_t)j * 1536 * 1024, TT, 1536, 1024, 0}; EpiQkvG e{P_WSB(OFF_Q), P_WSB(OFF_K), P_WSB(OFF_VT), P_IN(11) + j * 64, P_IN(12) + j * 64, ropeG_l}; gemm_phase(TID, BID, lds, g, e); }
        else { Gemm g{P_WSB(OFF_H), P_WSB(OFF_WINT) + (size_t)j * 768 * 1024, TT, 768, 1024, 0}; EpiWin e{P_WSB(OFF_CQ), P_WSB(OFF_CKV), P_WSB(OFF_KPE), P_WSF(OFF_SSQ), ropeM_l}; gemm_phase(TID, BID, lds, g, e); }
        break;
    case 2:
        if (mla) {
            { Gemm g{P_WSB(OFF_CQ), P_WSB(OFF_WUQT) + (size_t)j * 1536 * 384, l == 3 ? TL : TT, 1536, 384, 0};     EpiUq e{P_WSB(OFF_Q), P_WSF(OFF_SSQ), ropeM_l}; gemm_phase(TID, BID, lds, g, e); }
            { Gemm g{P_WSB(OFF_CKV), P_WSB(OFF_WUKVT) + (size_t)j * 2048 * 256, TT, 2048, 256, 0}; EpiUkv e{P_WSB(OFF_K), P_WSB(OFF_VT), P_WSF(OFF_SSQ)}; gemm_phase(TID, BID, lds, g, e); }
        }
        break;
    case 3: if (mla) attn_phase<true>(TID, BID, lds, p, l < 3); else attn_phase<false>(TID, BID, lds, p, l < 3); break;
    case 4: {
        Gemm g{P_WSB(OFF_H), (mla ? P_WSB(OFF_WOMT) : P_WSB(OFF_WOGT)) + (size_t)j * 1024 * 1024, TL, 1024, 1024, l < 3 ? NSPLIT_WO : 0};
        if (l == 0) { EpiRes<true> e{P_WSB(OFF_Z), P_IN(0), P_IN(2), P_WSF(OFF_STATS), nullptr, nullptr, modl + 2048, P_WSB(OFF_PART)}; gemm_phase(TID, BID, lds, g, e); }
        else { EpiRes<false> e{P_WSB(OFF_Z), nullptr, nullptr, P_WSF(OFF_STATS), P_IN(6) + (l * 2 - 1) * 1024, P_IN(7) + (l * 2 - 1) * 1024, modl + 2048, P_WSB(OFF_PART)}; gemm_phase(TID, BID, lds, g, e); }
        break; }
    case 5: prep_phase(TID, BID, p, l, 1, Mres); break;
    case 6: { Gemm g{P_WSB(OFF_H), P_WSB(OFF_W1T) + (size_t)l * 4096 * 1024, Mres, 4096, 1024, 0}; EpiMlp1 e{P_WSB(OFF_U)}; gemm_phase(TID, BID, lds, g, e); break; }
    case 7: { Gemm g{P_WSB(OFF_U), P_WSB(OFF_W2T) + (size_t)l * 1024 * 4096, TL, 1024, 4096, l < 3 ? NSPLIT_M2 : 0}; EpiRes<false> e{P_WSB(OFF_Z), nullptr, nullptr, P_WSF(OFF_STATS), P_IN(6) + (l * 2) * 1024, P_IN(7) + (l * 2) * 1024, modl + 5120, P_WSB(OFF_PART)}; gemm_phase(TID, BID, lds, g, e); break; }
    }
}

__global__ void __launch_bounds__(512) mega(Params p, int ph_lo, int ph_hi) {
    extern __shared__ __attribute__((aligned(16))) unsigned char shm[];
    cg::grid_group grid = cg::this_grid();
    volatile LAS unsigned* st = (volatile LAS unsigned*)((LAS unsigned char*)shm + LDS_STAGE);
    unsigned* bar = (unsigned*)(GAS unsigned*)(p.ws + OFF_BAR);
    if (threadIdx.x == 0) { st[0] = 0u; st[1] = 0u; (void)xb_add(&bar[XB_XCNT(xb_xcc_id())], 1u); }
    __syncthreads();
    if (ph_lo < -1000) grid.sync();
    bool first = true, dup = false;
    for (int ph = ph_lo; ph < ph_hi; ++ph) {
        if (phase_empty(ph)) continue;
        int tid = threadIdx.x, bid = blockIdx.x; unsigned lbase = 0;
        asm volatile("" : "+v"(tid), "+s"(bid), "+s"(lbase));
        if (!first) xcd_barrier(bar, st, tid);
        first = false;
        run_phase(tid, bid, (LAS unsigned char*)shm + lbase, p, ph);
#ifdef PROBE_DUP
        if ((ph == 0 ? ((PROBE_DUP >> 8) & 1) : (ph < NPHASE - 1 && ((PROBE_DUP >> ((ph - 1) & 7)) & 1))) && !dup) { dup = true; --ph; } else dup = false;
#endif
    }
}

extern "C" void kernel_launch(void* const* d_in, const int* in_sizes, int n_in, void* d_out, int out_size, void* d_ws, size_t ws_size, hipStream_t stream) {
    static int grid_blocks = 0;
    if (!grid_blocks) {
        int dev = 0, cus = 0, per_cu = 0;
        hipGetDevice(&dev);
        hipDeviceGetAttribute(&cus, hipDeviceAttributeMultiprocessorCount, dev);
        hipFuncSetAttribute((const void*)mega, hipFuncAttributeMaxDynamicSharedMemorySize, LDS_BYTES);
        hipOccupancyMaxActiveBlocksPerMultiprocessor(&per_cu, mega, 512, LDS_BYTES);
        if (per_cu < 1) per_cu = 1;
        grid_blocks = cus * per_cu;
    }
    Params p{};
    for (int i = 0; i < 20; ++i) p.in[i] = (const float*)d_in[i];
    p.out = (float*)d_out; p.ws = (unsigned char*)d_ws;
    if (WS_NEED > ws_size) { fprintf(stderr, "workspace too small: need %zu have %zu\n", (size_t)WS_NEED, ws_size); return; }
    hipMemsetAsync(d_ws, 0, BAR_BYTES, stream);
#if MK_SINGLE
    int lo = 0, hi = NPHASE;
    void* args[] = {&p, &lo, &hi};
    hipError_t e = hipLaunchCooperativeKernel((const void*)mega, dim3(grid_blocks), dim3(512), args, LDS_BYTES, stream);
    if (e != hipSuccess) fprintf(stderr, "cooperative launch failed: %s (grid %d)\n", hipGetErrorString(e), grid_blocks);
#else
    for (int ph = 0; ph < NPHASE; ++ph) {
        if (phase_empty(ph)) continue;
        mega<<<dim3(grid_blocks), dim3(512), LDS_BYTES, stream>>>(p, ph, ph + 1);
    }
#endif
}
```

```cpp
#include <hip/hip_runtime.h>
#include <hip/hip_cooperative_groups.h>
#include <cstdio>
namespace cg = cooperative_groups;

#ifndef MK_SINGLE
#define MK_SINGLE 1
#endif

#define DI __device__ __forceinline__
#define LAS __attribute__((address_space(3)))
typedef unsigned short bf16_t;
typedef short bf16x8 __attribute__((ext_vector_type(8)));
typedef float f32x4 __attribute__((ext_vector_type(4)));
typedef float f32x2 __attribute__((ext_vector_type(2)));
typedef float f32x16 __attribute__((ext_vector_type(16)));
typedef unsigned u32x4 __attribute__((ext_vector_type(4)));
typedef unsigned u32x2 __attribute__((ext_vector_type(2)));
typedef __bf16 bf2_t __attribute__((ext_vector_type(2)));
typedef short s16x4 __attribute__((ext_vector_type(4)));

constexpr int TL = 16384, TC = 2048, TT = 18432, DM = 1024, NKEY = 2304;
constexpr float LN_EPS = 1e-6f;
constexpr float ALPHA = 1.681792830507429f;
constexpr int LDS_STAGE = 131072;
constexpr int LDS_ROPE = LDS_STAGE + 64;
constexpr int LDS_BYTES = LDS_ROPE + 8192 + 4096;

constexpr size_t al256(size_t x) { return (x + 255) & ~(size_t)255; }
constexpr size_t OFF_BAR = 0;
constexpr size_t BAR_BYTES = 16384;
constexpr size_t OFF_MOD = OFF_BAR + BAR_BYTES;
constexpr size_t OFF_ROPEG = OFF_MOD + al256((size_t)4 * 9 * 6144 * 4);
constexpr size_t OFF_ROPEM = OFF_ROPEG + al256(64 * 16 * 2 * 4);
constexpr size_t OFF_STATS = OFF_ROPEM + al256(64 * 8 * 2 * 4);
constexpr size_t OFF_SSQ = OFF_STATS + al256((size_t)TT * 2 * 4);
constexpr size_t OFF_Z = OFF_SSQ + al256((size_t)TT * 20 * 4);
constexpr size_t OFF_W1T = OFF_Z + al256((size_t)TT * 1024 * 2);
constexpr size_t OFF_W2T = OFF_W1T + al256((size_t)4 * 4096 * 1024 * 2);
constexpr size_t OFF_QKVT = OFF_W2T + al256((size_t)4 * 4096 * 1024 * 2);
constexpr size_t OFF_WOGT = OFF_QKVT + al256((size_t)2 * 1536 * 1024 * 2);
constexpr size_t OFF_WINT = OFF_WOGT + al256((size_t)2 * 1024 * 1024 * 2);
constexpr size_t OFF_WUQT = OFF_WINT + al256((size_t)2 * 768 * 1024 * 2);
constexpr size_t OFF_WUKVT = OFF_WUQT + al256((size_t)2 * 1536 * 384 * 2);
constexpr size_t OFF_WOMT = OFF_WUKVT + al256((size_t)2 * 2048 * 256 * 2);
constexpr size_t OFF_H = OFF_WOMT + al256((size_t)2 * 1024 * 1024 * 2);
constexpr size_t OFF_R1 = OFF_H + al256((size_t)TT * 1024 * 2);
constexpr size_t OFF_Q = OFF_R1;
constexpr size_t OFF_K = OFF_Q + al256((size_t)TT * 1536 * 2);
constexpr size_t OFF_KPE = OFF_K + al256((size_t)8 * 16 * NKEY * 64 * 2);
constexpr size_t OFF_VT = OFF_KPE + al256((size_t)8 * NKEY * 32 * 2);
constexpr size_t OFF_CQ = OFF_VT + al256((size_t)8 * 16 * 64 * NKEY * 2);
constexpr size_t OFF_CKV = OFF_CQ + al256((size_t)TT * 384 * 2);
constexpr size_t END_MIX = OFF_CKV + al256((size_t)TT * 256 * 2);
constexpr size_t OFF_U = OFF_R1;
constexpr size_t END_U = OFF_U + al256((size_t)TT * 4096 * 2);
constexpr size_t OFF_PART = END_MIX > END_U ? END_MIX : END_U;
constexpr size_t WS_NEED = OFF_PART + al256((size_t)8 * TC * 1024 * 2);
static_assert(WS_NEED <= (size_t)402653184, "workspace budget");
constexpr int NSPLIT_WO = 4, NSPLIT_M2 = 8;

struct Params { const float* in[20]; float* out; unsigned char* ws; };
#define GAS __attribute__((address_space(1)))
#define P_IN(i) ((const float*)(GAS const float*)(p.in[i]))
#define P_WSF(off) ((float*)(GAS float*)(p.ws + (off)))
#define P_WSB(off) ((bf16_t*)(GAS bf16_t*)(p.ws + (off)))
#define P_OUT ((float*)(GAS float*)(p.out))


DI unsigned pk_bf16(float lo, float hi) {
    f32x2 v = {lo, hi};
    bf2_t r = __builtin_convertvector(v, bf2_t);
    return __builtin_bit_cast(unsigned, r);
}
DI f32x4 unpk4(u32x2 v) { f32x4 r; r[0] = __builtin_bit_cast(float, v[0] << 16); r[1] = __builtin_bit_cast(float, v[0] & 0xffff0000u); r[2] = __builtin_bit_cast(float, v[1] << 16); r[3] = __builtin_bit_cast(float, v[1] & 0xffff0000u); return r; }
DI bf16_t to_bf16(float f) { return (bf16_t)(pk_bf16(f, 0.f) & 0xffffu); }
DI float shx(float v, int m, int lane) { return __builtin_bit_cast(float, __builtin_amdgcn_ds_bpermute((lane ^ m) << 2, __builtin_bit_cast(int, v))); }
DI float wave_sum(float v, int lane) {
#pragma unroll
    for (int o = 32; o >= 1; o >>= 1) v += shx(v, o, lane);
    return v;
}

DI int perm32(int rho) { const int n = rho >> 4, i = rho & 15; return 8 * (i >> 2) + 4 * n + (i & 3); }
DI int rope32(int rho) { const int n = rho >> 4, fq = (rho >> 2) & 3, j = rho & 3; return 16 * (fq >> 1) + 4 * (fq & 1) + 8 * n + j; }
enum { MODE_NAT = 0, MODE_P8 = 1, MODE_GQA = 2, MODE_WIN = 3, MODE_UQ = 4, MODE_P8W = 5 };
DI int srccol(int mode, int nidx) {
    const int rho = nidx & 31;
    if (mode == MODE_NAT) return nidx;
    if (mode == MODE_P8) return (nidx & ~31) + perm32(rho);
    if (mode == MODE_P8W) { const int tc = nidx & 255, bj = tc >> 7, wc = (tc >> 5) & 3; return (nidx & ~255) + 64 * wc + 32 * bj + perm32(rho); }
    if (mode == MODE_GQA) {
        const int tile = nidx >> 8, tc = nidx & 255, bj = tc >> 7, wc = (tc >> 5) & 3, n = rho >> 4, fq = (rho >> 2) & 3, j = rho & 3;
        return 64 * (4 * tile + wc) + 32 * (fq >> 1) + 8 * (fq & 1) + 16 * bj + 4 * n + j;
    }
    if (mode == MODE_WIN) {
        if (nidx < 640) return (nidx & ~31) + perm32(rho);
        if (nidx < 672) return 640 + rope32(rho);
        return -1;
    }
    { const int part = (nidx >> 5) % 3; return (nidx & ~31) + (part == 2 ? rope32(rho) : perm32(rho)); }
}

DI void transpose_job(const int TID, const int BID, LAS unsigned char* lds, const float* W, int K, int Nsrc, int Npad, bf16_t* Bt, int mode, const float* kscale) {
    const int tid = TID;
    const int nkt = K >> 6, ntile = (Npad >> 6) * nkt;
    LAS unsigned* tl = (LAS unsigned*)lds;
    const int kp = tid >> 4, dq = tid & 15;
    for (int t = BID; t < ntile; t += gridDim.x) {
        const int n0 = (t / nkt) << 6, k0 = (t % nkt) << 6;
        const int sc = srccol(mode, n0 + 4 * dq);
        f32x4 va = {0.f, 0.f, 0.f, 0.f}, vb = va;
        if (sc >= 0) {
            va = *(const f32x4*)(W + (size_t)(k0 + 2 * kp) * Nsrc + sc); vb = *(const f32x4*)(W + (size_t)(k0 + 2 * kp + 1) * Nsrc + sc);
            if (kscale) { va *= kscale[k0 + 2 * kp]; vb *= kscale[k0 + 2 * kp + 1]; }
        }
#pragma unroll
        for (int e = 0; e < 4; ++e) tl[(4 * dq + e) * 33 + kp] = pk_bf16(va[e], vb[e]);
        __syncthreads();
        {
            const int n2 = tid >> 3, c2 = tid & 7;
            u32x4 o;
#pragma unroll
            for (int i = 0; i < 4; ++i) o[i] = tl[n2 * 33 + c2 * 4 + i];
            *(u32x4*)(Bt + (size_t)(n0 + n2) * K + k0 + c2 * 8) = o;
        }
        __syncthreads();
    }
}

DI void init_phase(const int TID, const int BID, LAS unsigned char* lds, const Params& p) {
    const int tid = TID;
    {
        const int i = BID * 512 + tid;
        if (i < 1024) { const int pos = i >> 4, f = i & 15; const float inv = powf(10000.f, -(float)f / 16.f); const float a = (float)pos * inv; P_WSF(OFF_ROPEG)[2 * i] = cosf(a); P_WSF(OFF_ROPEG)[2 * i + 1] = sinf(a); }
        else if (i < 1536) { const int i2 = i - 1024; const int pos = i2 >> 3, f = i2 & 7; const float inv = powf(10000.f, -(float)f / 8.f); const float a = (float)pos * inv; P_WSF(OFF_ROPEM)[2 * i2] = cosf(a); P_WSF(OFF_ROPEM)[2 * i2 + 1] = sinf(a); }
    }
    {
        LAS float* sl = (LAS float*)lds;
        LAS float* part = sl + 9216;
        for (int i = tid; i < 9216; i += 512) { const int j = i >> 10, k = i & 1023; const float cv = j < 8 ? P_IN(1)[j * 1024 + k] : P_IN(3)[k]; sl[i] = cv / (1.f + expf(-cv)); }
        __syncthreads();
        for (int item = BID; item < 384; item += gridDim.x) {
            const int l = item / 96, n0 = (item % 96) * 64, kg = tid >> 4, c4 = (tid & 15) * 4;
            const float* w = P_IN(4) + ((size_t)l * 1024 + kg * 32) * 6144 + n0 + c4;
            f32x4 acc9[9];
#pragma unroll
            for (int j = 0; j < 9; ++j) acc9[j] = (f32x4){0.f, 0.f, 0.f, 0.f};
#pragma unroll 8
            for (int k = 0; k < 32; ++k) {
                const f32x4 wv = *(const f32x4*)(w + (size_t)k * 6144);
                const LAS float* sp = sl + kg * 32 + k;
#pragma unroll
                for (int j = 0; j < 9; ++j) acc9[j] += wv * sp[j * 1024];
            }
#pragma unroll
            for (int j = 0; j < 9; ++j) *(LAS f32x4*)(part + (kg * 9 + j) * 64 + c4) = acc9[j];
            __syncthreads();
            for (int i = tid; i < 576; i += 512) {
                const int j = i >> 6, c2 = i & 63;
                float sum = 0.f;
#pragma unroll 8
                for (int g = 0; g < 32; ++g) sum += part[g * 576 + i];
                P_WSF(OFF_MOD)[(size_t)(l * 9 + j) * 6144 + n0 + c2] = sum + P_IN(5)[l * 6144 + n0 + c2];
            }
            __syncthreads();
        }
    }
    for (int l = 0; l < 4; ++l) transpose_job(TID, BID, lds, P_IN(8) + (size_t)l * 1024 * 4096, 1024, 4096, 4096, P_WSB(OFF_W1T) + (size_t)l * 4096 * 1024, MODE_P8W, nullptr);
    for (int l = 0; l < 4; ++l) transpose_job(TID, BID, lds, P_IN(9) + (size_t)l * 4096 * 1024, 4096, 1024, 1024, P_WSB(OFF_W2T) + (size_t)l * 1024 * 4096, MODE_P8, nullptr);
    for (int j = 0; j < 2; ++j) {
        transpose_job(TID, BID, lds, P_IN(10) + (size_t)j * 1024 * 1536, 1024, 1536, 1536, P_WSB(OFF_QKVT) + (size_t)j * 1536 * 1024, MODE_GQA, nullptr);
        transpose_job(TID, BID, lds, P_IN(13) + (size_t)j * 1024 * 1024, 1024, 1024, 1024, P_WSB(OFF_WOGT) + (size_t)j * 1024 * 1024, MODE_P8, nullptr);
        transpose_job(TID, BID, lds, P_IN(14) + (size_t)j * 1024 * 672, 1024, 672, 768, P_WSB(OFF_WINT) + (size_t)j * 768 * 1024, MODE_WIN, nullptr);
        transpose_job(TID, BID, lds, P_IN(17) + (size_t)j * 384 * 1536, 384, 1536, 1536, P_WSB(OFF_WUQT) + (size_t)j * 1536 * 384, MODE_UQ, P_IN(15) + j * 384);
        transpose_job(TID, BID, lds, P_IN(18) + (size_t)j * 256 * 2048, 256, 2048, 2048, P_WSB(OFF_WUKVT) + (size_t)j * 2048 * 256, MODE_P8, P_IN(16) + j * 256);
        transpose_job(TID, BID, lds, P_IN(19) + (size_t)j * 1024 * 1024, 1024, 1024, 1024, P_WSB(OFF_WOMT) + (size_t)j * 1024 * 1024, MODE_P8, nullptr);
    }
}

template <int PR>
#define PCOL(i) ((((i) >> 1) << 9) + lane * 8 + (((i) & 1) << 2))
DI void prep_rows(const int lane, const Params& p, int l, int which, int rbeg, int rend, int gw, int nw) {
    for (int row = rbeg + gw * PR; row < rend; row += nw * PR) {
        const int mi = row < TL ? (row >> 11) : 8;
        const bool raw = (which == 0 && l == 0);
        f32x4 v[PR][4];
#pragma unroll
        for (int rr = 0; rr < PR; ++rr) {
            const int r2 = row + rr;
            if (raw) {
                const float* src = r2 < TL ? P_IN(0) + (size_t)r2 * 1024 : P_IN(2) + (size_t)(r2 - TL) * 1024;
#pragma unroll
                for (int i = 0; i < 4; ++i) v[rr][i] = *(const f32x4*)(src + PCOL(i));
            } else {
                const bf16_t* src = P_WSB(OFF_Z) + (size_t)r2 * 1024;
#pragma unroll
                for (int i = 0; i < 4; i += 2) { const u32x4 zz = *(const u32x4*)(src + PCOL(i)); const u32x2 zl = {zz[0], zz[1]}, zh = {zz[2], zz[3]}; v[rr][i] = unpk4(zl); v[rr][i + 1] = unpk4(zh); }
            }
        }
        if (row >= TL && !raw) {
            const bool rawres = (which == 1 && l == 0);
            const int lp = which ? l : l - 1;
            const float* gp = P_WSF(OFF_MOD) + (size_t)(lp * 9 + 8) * 6144 + (which ? 2048 : 5120);
            if (rawres) {
#pragma unroll
                for (int rr = 0; rr < PR; ++rr) {
                    const float* cs = P_IN(2) + (size_t)(row + rr - TL) * 1024;
#pragma unroll
                    for (int i = 0; i < 4; ++i) v[rr][i] = *(const f32x4*)(cs + PCOL(i));
                }
            } else {
                const int lj = which ? (l * 2 - 1) : (l * 2 - 2);
                const float* lg2 = P_IN(6) + lj * 1024; const float* lb2 = P_IN(7) + lj * 1024;
#pragma unroll
                for (int i = 0; i < 4; ++i) {
                    const f32x4 g = *(const f32x4*)(lg2 + PCOL(i)), b = *(const f32x4*)(lb2 + PCOL(i));
#pragma unroll
                    for (int rr = 0; rr < PR; ++rr) { const f32x2 st = *(const f32x2*)(P_WSF(OFF_STATS) + 2 * (row + rr)); v[rr][i] = (v[rr][i] - st[0]) * st[1] * g + b; }
                }
            }
#pragma unroll
            for (int i = 0; i < 4; ++i) {
                const int c = PCOL(i);
                const f32x4 gv = *(const f32x4*)(gp + c);
#pragma unroll
                for (int rr = 0; rr < PR; ++rr) {
                    const bf16_t* pp = P_WSB(OFF_PART) + (size_t)(row + rr - TL) * 1024 + c;
                    f32x4 a = unpk4(*(const u32x2*)pp);
#pragma unroll
                    for (int k = 1; k < NSPLIT_WO; ++k) a += unpk4(*(const u32x2*)(pp + (size_t)k * TC * 1024));
                    if (which == 0) {
#pragma unroll
                        for (int k = NSPLIT_WO; k < NSPLIT_M2; ++k) a += unpk4(*(const u32x2*)(pp + (size_t)k * TC * 1024));
                    }
                    v[rr][i] = v[rr][i] * ALPHA + gv * a;
                    { u32x2 zo; zo[0] = pk_bf16(v[rr][i][0], v[rr][i][1]); zo[1] = pk_bf16(v[rr][i][2], v[rr][i][3]); *(u32x2*)(P_WSB(OFF_Z) + (size_t)(row + rr) * 1024 + c) = zo; v[rr][i] = unpk4(zo); }
                }
            }
        }
        if (!raw) {
            const int li = which == 2 ? 7 : (which ? (l * 2) : (l * 2 - 1));
            const float* lg = P_IN(6) + li * 1024; const float* lb = P_IN(7) + li * 1024;
            float sm[PR], sq[PR];
#pragma unroll
            for (int rr = 0; rr < PR; ++rr) { float s = 0.f;
#pragma unroll
                for (int i = 0; i < 4; ++i) s += v[rr][i][0] + v[rr][i][1] + v[rr][i][2] + v[rr][i][3];
                sm[rr] = s; }
#pragma unroll
            for (int o = 32; o >= 1; o >>= 1)
#pragma unroll
                for (int rr = 0; rr < PR; ++rr) sm[rr] += shx(sm[rr], o, lane);
#pragma unroll
            for (int rr = 0; rr < PR; ++rr) { const float mean = sm[rr] * (1.f / 1024.f); sm[rr] = mean; float q = 0.f;
#pragma unroll
                for (int i = 0; i < 4; ++i) { v[rr][i] -= mean; q += v[rr][i][0] * v[rr][i][0] + v[rr][i][1] * v[rr][i][1] + v[rr][i][2] * v[rr][i][2] + v[rr][i][3] * v[rr][i][3]; }
                sq[rr] = q; }
#pragma unroll
            for (int o = 32; o >= 1; o >>= 1)
#pragma unroll
                for (int rr = 0; rr < PR; ++rr) sq[rr] += shx(sq[rr], o, lane);
#pragma unroll
            for (int rr = 0; rr < PR; ++rr) { sq[rr] = rsqrtf(sq[rr] * (1.f / 1024.f) + LN_EPS);
                if (which != 2 && lane == 0) { P_WSF(OFF_STATS)[2 * (row + rr)] = sm[rr]; P_WSF(OFF_STATS)[2 * (row + rr) + 1] = sq[rr]; } }
#pragma unroll
            for (int i = 0; i < 4; ++i) { const f32x4 g = *(const f32x4*)(lg + PCOL(i)), b = *(const f32x4*)(lb + PCOL(i));
#pragma unroll
                for (int rr = 0; rr < PR; ++rr) v[rr][i] = v[rr][i] * sq[rr] * g + b; }
        }
        if (which == 2) {
#pragma unroll
            for (int rr = 0; rr < PR; ++rr)
#pragma unroll
                for (int i = 0; i < 4; ++i) *(f32x4*)(P_OUT + (size_t)(row + rr) * 1024 + PCOL(i)) = v[rr][i];
        } else {
            const float* modp = P_WSF(OFF_MOD) + (size_t)(l * 9 + mi) * 6144 + (which ? 3072 : 0);
#pragma unroll
            for (int i = 0; i < 4; i += 2) {
                const f32x4 sh0 = *(const f32x4*)(modp + PCOL(i)), sc0 = *(const f32x4*)(modp + 1024 + PCOL(i));
                const f32x4 sh1 = *(const f32x4*)(modp + PCOL(i + 1)), sc1 = *(const f32x4*)(modp + 1024 + PCOL(i + 1));
#pragma unroll
                for (int rr = 0; rr < PR; ++rr) {
                    const f32x4 h0 = v[rr][i] * (sc0 + 1.f) + sh0, h1 = v[rr][i + 1] * (sc1 + 1.f) + sh1;
                    u32x4 o; o[0] = pk_bf16(h0[0], h0[1]); o[1] = pk_bf16(h0[2], h0[3]); o[2] = pk_bf16(h1[0], h1[1]); o[3] = pk_bf16(h1[2], h1[3]);
                    *(u32x4*)(P_WSB(OFF_H) + (size_t)(row + rr) * 1024 + PCOL(i)) = o;
                }
            }
        }
    }
}
DI void prep_phase(const int TID, const int BID, const Params& p, int l, int which, int M) {
    if (M > TL) prep_rows<1>(TID & 63, p, l, which, TL, M, BID * 8 + (TID >> 6), gridDim.x * 8);
    prep_rows<4>(TID & 63, p, l, which, 0, TL, BID * 8 + (TID >> 6), gridDim.x * 8);
}
DI void final_phase(const int TID, const int BID, const Params& p) {
    prep_rows<4>(TID & 63, p, 3, 2, 0, TL, BID * 8 + (TID >> 6), gridDim.x * 8);
}

constexpr int BM = 256, BK = 64, HALF = 128, HTB = HALF * BK * 2, NXCD = 8, WGM = 8;
DI int lds_byte(int r, int c) { const int st = (r >> 4) * 2 + (c >> 5), rr = r & 15, cc = c & 31, ob = rr * 64 + cc * 2; return st * 1024 + (ob ^ (((ob >> 9) & 1) << 5)); }
DI void stage_rc(int b, int& R, int& C) { const int st = b / 1024, sb = b % 1024, swz = sb ^ (((sb >> 9) & 1) << 5); R = (st >> 1) * 16 + swz / 64; C = (st & 1) * 32 + (swz % 64) / 2; }
struct Unit { int pm, pn, k0, nt, ks; };
struct Gemm { const bf16_t* A; const bf16_t* Bt; int M, N, K; int nsplit; };
struct StaticOrder {
    int nM, nN, nwg, G, c, K, S;
    DI void init(int M, int N, int K_, int S_, int G_, int c_) { nM = M / BM; nN = N / BM; nwg = nM * nN; G = G_; c = c_; K = K_; S = S_; }
    DI bool next(int i, Unit& u) const {
        const long L = (long)i * G + c;
        u.pm = 0; u.pn = 0; u.k0 = 0; u.nt = K / BK; u.ks = -1;
        if (L >= nwg) {
            const int e = (int)(L - nwg);
            if (e >= 8 * nN * S) return false;
            const int tile = e / S;
            u.ks = e - tile * S; u.pm = TL / BM + (tile & 7); u.pn = tile >> 3; u.nt = K / (BK * S); u.k0 = u.ks * (K / S);
            return true;
        }
        int wgid = (int)L; { const int q = nwg / NXCD, r = nwg % NXCD, xcd = wgid % NXCD, off = wgid / NXCD; wgid = (xcd < r ? xcd * (q + 1) : r * (q + 1) + (xcd - r) * q) + off; }
        const int nig = WGM * nN, gid = wgid / nig, fm = gid * WGM, gsz = (nM - fm) < WGM ? (nM - fm) : WGM;
        u.pm = fm + ((wgid % nig) % gsz); u.pn = (wgid % nig) / gsz; u.k0 = 0; u.nt = K / BK; u.ks = -1; return true;
    }
};
template <class Epi>
DI void gemm_phase(const int TID, const int BID, LAS unsigned char* lds, const Gemm g, const Epi& E) {
    const int tid = TID, wid = __builtin_amdgcn_readfirstlane(tid >> 6), lane = tid & 63, wr = wid >> 2, wc = wid & 3, fr = lane & 15, fq = lane >> 4;
    int K = g.K; asm volatile("" : "+s"(K));
    StaticOrder S; S.init(g.M, g.N, K, g.nsplit, (int)gridDim.x, BID);
    unsigned voffA[2];
#pragma unroll
    for (int i = 0; i < 2; ++i) { int R, C; stage_rc(tid * 16 + i * 8192, R, C); voffA[i] = (unsigned)(R * K + C) * 2u; }
    const size_t kstep = (size_t)(BK * 2);
    const size_t hstep = (size_t)HALF * K * 2;
    const size_t tstep = 2 * hstep;
    const unsigned ldsw = (unsigned)wid * 1024u;
    const int aoff = lds_byte(wr * 64 + fr, fq * 8), boff = lds_byte(wc * 32 + fr, fq * 8);
#define PG8_SA(b, h) (((b) * 2 + (h)) * HTB)
#define PG8_SB(b, h) ((4 + (b) * 2 + (h)) * HTB)
#define PG8_STAGE(bufoff, gbase) do { _Pragma("unroll") for (int _i = 0; _i < 2; ++_i) \
        __builtin_amdgcn_global_load_lds((const unsigned*)((const char*)(gbase) + voffA[_i]), (LAS unsigned*)(lds + (bufoff) + ldsw + _i * 8192), 16, 0, 0); } while (0)
#define PG8_LDA(dst, b, h) do { _Pragma("unroll") for (int m = 0; m < 4; ++m) _Pragma("unroll") for (int k = 0; k < 2; ++k) dst[m][k] = *(const LAS bf16x8*)(lds + PG8_SA(b, h) + aoff + m * 2048 + k * 1024); } while (0)
#define PG8_LDB(dst, b, h) do { _Pragma("unroll") for (int n = 0; n < 2; ++n) _Pragma("unroll") for (int k = 0; k < 2; ++k) dst[n][k] = *(const LAS bf16x8*)(lds + PG8_SB(b, h) + boff + n * 2048 + k * 1024); } while (0)
#define PG8_MMA(ai, bj, At, Bt) do { __builtin_amdgcn_s_setprio(1); _Pragma("unroll") for (int m = 0; m < 4; ++m) _Pragma("unroll") for (int n = 0; n < 2; ++n) _Pragma("unroll") for (int k = 0; k < 2; ++k) \
        acc[ai][bj][m][n] = __builtin_amdgcn_mfma_f32_16x16x32_bf16(Bt[n][k], At[m][k], acc[ai][bj][m][n], 0, 0, 0); __builtin_amdgcn_s_setprio(0); } while (0)
#define PG8_WAIT_V(n) asm volatile("s_waitcnt vmcnt(" #n ")" ::: "memory")
#define PG8_WAIT_L(n) asm volatile("s_waitcnt lgkmcnt(" #n ")" ::: "memory")
#define PG8_BAR __builtin_amdgcn_s_barrier()
#define PG8_SCHED __builtin_amdgcn_sched_barrier(0)
    Unit cur, nxt; int ui = 0;
    if (!S.next(0, cur)) return;
    f32x4 acc[2][2][4][2];
#pragma unroll
    for (int a = 0; a < 2; ++a)
#pragma unroll
        for (int b = 0; b < 2; ++b)
#pragma unroll
            for (int m = 0; m < 4; ++m)
#pragma unroll
                for (int n = 0; n < 2; ++n) acc[a][b][m][n] = (f32x4){0.f, 0.f, 0.f, 0.f};
    bf16x8 At[4][2], B0[2][2], B1[2][2];
    const char* cA = (const char*)g.A + (size_t)cur.pm * tstep + (size_t)cur.k0 * 2; const char* cB = (const char*)g.Bt + (size_t)cur.pn * tstep + (size_t)cur.k0 * 2;
    PG8_STAGE(PG8_SB(0, 0), cB); PG8_STAGE(PG8_SA(0, 0), cA); PG8_STAGE(PG8_SB(0, 1), cB + hstep); PG8_STAGE(PG8_SA(0, 1), cA + hstep);
    if (wr == 1) PG8_BAR;
    PG8_WAIT_V(4); PG8_BAR;
    PG8_STAGE(PG8_SB(1, 0), cB + kstep); PG8_STAGE(PG8_SA(1, 0), cA + kstep); PG8_STAGE(PG8_SB(1, 1), cB + hstep + kstep);
    PG8_WAIT_V(6); PG8_BAR;
    for (;;) {
        const bool has_next = S.next(ui + 1, nxt);
        const char* nA = has_next ? (const char*)g.A + (size_t)nxt.pm * tstep + (size_t)nxt.k0 * 2 : cA; const char* nB = has_next ? (const char*)g.Bt + (size_t)nxt.pn * tstep + (size_t)nxt.k0 * 2 : cB;
        const int nt = cur.nt;
        for (int t = 0; t < nt; t += 2) {
            const bool last = (t == nt - 2);
            const char* a1 = cA + (size_t)(t + 1) * kstep;
            const char* a2 = last ? nA : cA + (size_t)(t + 2) * kstep; const char* b2 = last ? nB : cB + (size_t)(t + 2) * kstep;
            const char* a3 = a2 + kstep; const char* b3 = b2 + kstep;
            PG8_LDB(B0, 0, 0); PG8_SCHED; PG8_LDA(At, 0, 0); PG8_STAGE(PG8_SA(1, 1), a1 + hstep);
            PG8_WAIT_L(8); PG8_BAR; PG8_WAIT_L(0); PG8_MMA(0, 0, At, B0); PG8_BAR; PG8_SCHED;
            PG8_LDB(B1, 0, 1); PG8_STAGE(PG8_SB(0, 0), b2);
            PG8_BAR; PG8_WAIT_L(0); PG8_MMA(0, 1, At, B1); PG8_BAR;
            PG8_LDA(At, 0, 1); PG8_STAGE(PG8_SA(0, 0), a2);
            PG8_BAR; PG8_WAIT_L(0); PG8_MMA(1, 0, At, B0); PG8_BAR; PG8_SCHED;
            PG8_STAGE(PG8_SB(0, 1), b2 + hstep);
            PG8_WAIT_V(6); PG8_BAR; PG8_MMA(1, 1, At, B1); PG8_BAR;
            PG8_LDB(B0, 1, 0); PG8_SCHED; PG8_LDA(At, 1, 0); PG8_STAGE(PG8_SA(0, 1), a2 + hstep);
            PG8_WAIT_L(8); PG8_BAR; PG8_WAIT_L(0); PG8_MMA(0, 0, At, B0); PG8_BAR; PG8_SCHED;
            PG8_LDB(B1, 1, 1); PG8_STAGE(PG8_SB(1, 0), b3);
            PG8_BAR; PG8_WAIT_L(0); PG8_MMA(0, 1, At, B1); PG8_BAR;
            PG8_LDA(At, 1, 1); PG8_STAGE(PG8_SA(1, 0), a3);
            PG8_BAR; PG8_WAIT_L(0); PG8_MMA(1, 0, At, B0); PG8_BAR; PG8_SCHED;
            PG8_STAGE(PG8_SB(1, 1), b3 + hstep);
            PG8_WAIT_V(6); PG8_BAR; PG8_MMA(1, 1, At, B1); PG8_BAR;
        }
        E(acc, cur, wr, wc, fr, fq);
        if (!has_next) break;
#pragma unroll
        for (int a = 0; a < 2; ++a)
#pragma unroll
            for (int b = 0; b < 2; ++b)
#pragma unroll
                for (int m = 0; m < 4; ++m)
#pragma unroll
                    for (int n = 0; n < 2; ++n) acc[a][b][m][n] = (f32x4){0.f, 0.f, 0.f, 0.f};
        cur = nxt; cA = nA; cB = nB; ++ui;
    }
    PG8_WAIT_V(0);
    if (wr == 0) PG8_BAR;
    PG8_BAR;
#undef PG8_SA
#undef PG8_SB
#undef PG8_STAGE
#undef PG8_LDA
#undef PG8_LDB
#undef PG8_MMA
#undef PG8_WAIT_V
#undef PG8_WAIT_L
#undef PG8_BAR
#undef PG8_SCHED
}

typedef f32x4 Acc[2][2][4][2];

template <bool FIRST> struct EpiRes {
    bf16_t* z; const float* xin; const float* cin; const float* stats; const float* lng; const float* lnb; const float* gate; bf16_t* part;
    DI void operator()(const Acc& acc, const Unit& u, int wr, int wc, int fr, int fq) const {
        const int rowb = u.pm * BM, row0 = rowb + wr * 64 + fr, col0 = u.pn * BM + wc * 32 + 8 * fq;
        if (u.ks >= 0) {
            bf16_t* pb = part + ((size_t)u.ks * TC + (row0 - TL)) * 1024 + col0;
#pragma unroll
            for (int ai = 0; ai < 2; ++ai)
#pragma unroll
                for (int m = 0; m < 4; ++m)
#pragma unroll
                    for (int bj = 0; bj < 2; ++bj) {
                        const f32x4 a = acc[ai][bj][m][0], c = acc[ai][bj][m][1];
                        u32x4 o; o[0] = pk_bf16(a[0], a[1]); o[1] = pk_bf16(a[2], a[3]); o[2] = pk_bf16(c[0], c[1]); o[3] = pk_bf16(c[2], c[3]);
                        *(u32x4*)(pb + (size_t)(ai * HALF + m * 16) * 1024 + bj * HALF) = o;
                    }
            return;
        }
        const int mi = rowb < TL ? (rowb >> 11) : 8;
        const float* gp = gate + (size_t)mi * 6144;
        f32x2 st[2][4];
        if (!FIRST) {
#pragma unroll
            for (int ai = 0; ai < 2; ++ai)
#pragma unroll
                for (int m = 0; m < 4; ++m) st[ai][m] = *(const f32x2*)(stats + 2 * (row0 + ai * HALF + m * 16));
        }
#pragma unroll
        for (int bj = 0; bj < 2; ++bj) {
            const int c = col0 + bj * HALF;
            const f32x4 gv0 = *(const f32x4*)(gp + c), gv1 = *(const f32x4*)(gp + c + 4);
            f32x4 lg0 = {0.f, 0.f, 0.f, 0.f}, lg1 = lg0, lb0 = lg0, lb1 = lg0;
            if (!FIRST) { lg0 = *(const f32x4*)(lng + c); lg1 = *(const f32x4*)(lng + c + 4); lb0 = *(const f32x4*)(lnb + c); lb1 = *(const f32x4*)(lnb + c + 4); }
#pragma unroll
            for (int ai = 0; ai < 2; ++ai) {
                u32x4 zq[4]; f32x4 xa[4], xb[4];
#pragma unroll
                for (int m = 0; m < 4; ++m) {
                    const int r = row0 + ai * HALF + m * 16;
                    if (FIRST) { const float* src = r < TL ? xin + (size_t)r * 1024 : cin + (size_t)(r - TL) * 1024; xa[m] = *(const f32x4*)(src + c); xb[m] = *(const f32x4*)(src + c + 4); }
                    else zq[m] = *(const u32x4*)(z + (size_t)r * 1024 + c);
                }
                __builtin_amdgcn_sched_barrier(0);
#pragma unroll
                for (int m = 0; m < 4; ++m) {
                    const int r = row0 + ai * HALF + m * 16;
                    f32x4 y0, y1;
                    if (FIRST) { y0 = xa[m]; y1 = xb[m]; }
                    else { const u32x2 zl = {zq[m][0], zq[m][1]}, zh = {zq[m][2], zq[m][3]};
                           y0 = (unpk4(zl) - st[ai][m][0]) * st[ai][m][1] * lg0 + lb0; y1 = (unpk4(zh) - st[ai][m][0]) * st[ai][m][1] * lg1 + lb1; }
                    y0 = y0 * ALPHA + gv0 * acc[ai][bj][m][0]; y1 = y1 * ALPHA + gv1 * acc[ai][bj][m][1];
                    u32x4 o; o[0] = pk_bf16(y0[0], y0[1]); o[1] = pk_bf16(y0[2], y0[3]); o[2] = pk_bf16(y1[0], y1[1]); o[3] = pk_bf16(y1[2], y1[3]);
                    *(u32x4*)(z + (size_t)r * 1024 + c) = o;
                }
                __builtin_amdgcn_sched_barrier(0);
            }
        }
    }
};
struct EpiMlp1 {
    bf16_t* U;
    DI void operator()(const Acc& acc, const Unit& u, int wr, int wc, int fr, int fq) const {
        const int row0 = u.pm * BM + wr * 64 + fr, col0 = u.pn * BM + wc * 64 + 8 * fq;
#pragma unroll
        for (int ai = 0; ai < 2; ++ai)
#pragma unroll
            for (int m = 0; m < 4; ++m) {
                bf16_t* rp = U + (size_t)(row0 + ai * HALF + m * 16) * 4096 + col0;
#pragma unroll
                for (int bj = 0; bj < 2; ++bj) {
                    f32x4 a = acc[ai][bj][m][0], b = acc[ai][bj][m][1];
#pragma unroll
                    for (int j = 0; j < 4; ++j) { a[j] = a[j] > 0.f ? a[j] * a[j] : 0.f; b[j] = b[j] > 0.f ? b[j] * b[j] : 0.f; }
                    u32x4 o; o[0] = pk_bf16(a[0], a[1]); o[1] = pk_bf16(a[2], a[3]); o[2] = pk_bf16(b[0], b[1]); o[3] = pk_bf16(b[2], b[3]);
                    *(u32x4*)(rp + bj * 32) = o;
                }
            }
    }
};
struct EpiQkvG {
    bf16_t* Q; bf16_t* Kd; bf16_t* Vt; const float* qn; const float* kn; const LAS float* tab;
    DI void operator()(const Acc& acc, const Unit& u, int wr, int wc, int fr, int fq) const {
        const int rowb = u.pm * BM; const bool latent = rowb < TL;
        const int b = latent ? (rowb >> 11) : ((rowb - TL) >> 8);
        const int s0 = latent ? (rowb & 2047) : 0, kp0 = latent ? 256 + s0 : 0;
        const int tile = u.pn, dbase = 32 * (fq >> 1) + 8 * (fq & 1);
        if (tile <= 4) {
            const float* gn = tile < 4 ? qn : kn;
            f32x4 g[2][2];
#pragma unroll
            for (int bj = 0; bj < 2; ++bj)
#pragma unroll
                for (int n = 0; n < 2; ++n) g[bj][n] = *(const f32x4*)(gn + dbase + 16 * bj + 4 * n);
#pragma unroll
            for (int ai = 0; ai < 2; ++ai)
#pragma unroll
                for (int m = 0; m < 4; ++m) {
                    const int rl = ai * HALF + wr * 64 + m * 16 + fr, r = rowb + rl;
                    float ss = 0.f;
#pragma unroll
                    for (int bj = 0; bj < 2; ++bj)
#pragma unroll
                        for (int n = 0; n < 2; ++n) { const f32x4 a = acc[ai][bj][m][n]; ss += a[0] * a[0] + a[1] * a[1] + a[2] * a[2] + a[3] * a[3]; }
                    ss += shx(ss, 16, 16 * fq + fr); ss += shx(ss, 32, 16 * fq + fr);
                    const float rstd = rsqrtf(ss * (1.f / 64.f) + LN_EPS);
                    f32x4 v[2][2];
#pragma unroll
                    for (int bj = 0; bj < 2; ++bj)
#pragma unroll
                        for (int n = 0; n < 2; ++n) v[bj][n] = acc[ai][bj][m][n] * rstd * g[bj][n];
                    if (latent) {
                        const int s = s0 + rl, pos = (fq >> 1) ? (s & 63) : (s >> 6);
#pragma unroll
                        for (int n = 0; n < 2; ++n) {
                            const LAS float* tp = tab + (pos * 16 + 8 * (fq & 1) + 4 * n) * 2;
                            const f32x4 t0 = *(const LAS f32x4*)tp, t1 = *(const LAS f32x4*)(tp + 4);
                            const f32x4 cs = {t0[0], t0[2], t1[0], t1[2]}, sn = {t0[1], t0[3], t1[1], t1[3]};
                            const f32x4 x1 = v[0][n], x2 = v[1][n];
                            v[0][n] = x1 * cs - x2 * sn; v[1][n] = x2 * cs + x1 * sn;
                        }
                    }
#pragma unroll
                    for (int bj = 0; bj < 2; ++bj) {
                        u32x4 o; o[0] = pk_bf16(v[bj][0][0], v[bj][0][1]); o[1] = pk_bf16(v[bj][0][2], v[bj][0][3]); o[2] = pk_bf16(v[bj][1][0], v[bj][1][1]); o[3] = pk_bf16(v[bj][1][2], v[bj][1][3]);
                        bf16_t* dst = tile < 4 ? Q + (size_t)r * 1024 + (tile * 4 + wc) * 64 + dbase + 16 * bj
                                               : Kd + ((size_t)(b * 4 + wc) * NKEY + kp0 + rl) * 64 + dbase + 16 * bj;
                        *(u32x4*)dst = o;
                    }
                }
        } else {
#pragma unroll
            for (int ai = 0; ai < 2; ++ai)
#pragma unroll
                for (int m = 0; m < 4; ++m) {
                    const int rl = ai * HALF + wr * 64 + m * 16 + fr;
                    bf16_t* vb = Vt + ((size_t)(b * 4 + wc) * NKEY + kp0 + rl) * 64 + dbase;
#pragma unroll
                    for (int bj = 0; bj < 2; ++bj) {
                        const f32x4 a = acc[ai][bj][m][0], c = acc[ai][bj][m][1];
                        u32x4 o; o[0] = pk_bf16(a[0], a[1]); o[1] = pk_bf16(a[2], a[3]); o[2] = pk_bf16(c[0], c[1]); o[3] = pk_bf16(c[2], c[3]);
                        *(u32x4*)(vb + 16 * bj) = o;
                    }
                }
        }
    }
};
struct EpiWin {
    bf16_t* cq; bf16_t* ckv; bf16_t* kpe; float* ssq; const LAS float* tab;
    DI void operator()(const Acc& acc, const Unit& u, int wr, int wc, int fr, int fq) const {
        const int rowb = u.pm * BM; const bool latent = rowb < TL;
        const int b = latent ? (rowb >> 11) : ((rowb - TL) >> 8);
        const int s0 = latent ? (rowb & 2047) : 0, kp0 = latent ? 256 + s0 : 0;
#pragma unroll
        for (int bj = 0; bj < 2; ++bj) {
            const int L = u.pn * BM + bj * HALF + wc * 32;
            if (L < 640) {
#pragma unroll
                for (int ai = 0; ai < 2; ++ai)
#pragma unroll
                    for (int m = 0; m < 4; ++m) {
                        const int r = rowb + ai * HALF + wr * 64 + m * 16 + fr;
                        const f32x4 a = acc[ai][bj][m][0], c = acc[ai][bj][m][1];
                        float ss = a[0] * a[0] + a[1] * a[1] + a[2] * a[2] + a[3] * a[3] + c[0] * c[0] + c[1] * c[1] + c[2] * c[2] + c[3] * c[3];
                        ss += shx(ss, 16, 16 * fq + fr); ss += shx(ss, 32, 16 * fq + fr);
                        if (fq == 0) ssq[(size_t)r * 20 + (L >> 5)] = ss;
                        u32x4 o; o[0] = pk_bf16(a[0], a[1]); o[1] = pk_bf16(a[2], a[3]); o[2] = pk_bf16(c[0], c[1]); o[3] = pk_bf16(c[2], c[3]);
                        bf16_t* dst = L < 384 ? cq + (size_t)r * 384 + L + 8 * fq : ckv + (size_t)r * 256 + (L - 384) + 8 * fq;
                        *(u32x4*)dst = o;
                    }
            } else if (L == 640) {
#pragma unroll
                for (int ai = 0; ai < 2; ++ai)
#pragma unroll
                    for (int m = 0; m < 4; ++m) {
                        const int rl = ai * HALF + wr * 64 + m * 16 + fr;
                        f32x4 x1 = acc[ai][bj][m][0], x2 = acc[ai][bj][m][1];
                        if (latent) {
                            const int s = s0 + rl, pos = (fq >> 1) ? (s & 63) : (s >> 6);
                            const LAS float* tp = tab + (pos * 8 + 4 * (fq & 1)) * 2;
                            const f32x4 t0 = *(const LAS f32x4*)tp, t1 = *(const LAS f32x4*)(tp + 4);
                            const f32x4 cs = {t0[0], t0[2], t1[0], t1[2]}, sn = {t0[1], t0[3], t1[1], t1[3]};
                            const f32x4 y1 = x1 * cs - x2 * sn, y2 = x2 * cs + x1 * sn; x1 = y1; x2 = y2;
                        }
                        bf16_t* dst = kpe + ((size_t)b * NKEY + kp0 + rl) * 32 + 16 * (fq >> 1) + 4 * (fq & 1);
                        u32x2 o1, o2; o1[0] = pk_bf16(x1[0], x1[1]); o1[1] = pk_bf16(x1[2], x1[3]); o2[0] = pk_bf16(x2[0], x2[1]); o2[1] = pk_bf16(x2[2], x2[3]);
                        *(u32x2*)dst = o1; *(u32x2*)(dst + 8) = o2;
                    }
            }
        }
    }
};
struct EpiUq {
    bf16_t* Q; const float* ssq; const LAS float* tab;
    DI void operator()(const Acc& acc, const Unit& u, int wr, int wc, int fr, int fq) const {
        const int rowb = u.pm * BM; const bool latent = rowb < TL;
        const int s0 = latent ? (rowb & 2047) : 0;
        float rs[2][4];
        {
            f32x4 qv[2][4];
            const int slot = fq < 3 ? fq : 0;
#pragma unroll
            for (int ai = 0; ai < 2; ++ai)
#pragma unroll
                for (int m = 0; m < 4; ++m) qv[ai][m] = *(const f32x4*)(ssq + (size_t)(rowb + ai * HALF + wr * 64 + m * 16 + fr) * 20 + slot * 4);
#pragma unroll
            for (int ai = 0; ai < 2; ++ai)
#pragma unroll
                for (int m = 0; m < 4; ++m) {
                    float t = fq < 3 ? (qv[ai][m][0] + qv[ai][m][1]) + (qv[ai][m][2] + qv[ai][m][3]) : 0.f;
                    t += shx(t, 16, 16 * fq + fr); t += shx(t, 32, 16 * fq + fr);
                    rs[ai][m] = rsqrtf(t * (1.f / 384.f) + LN_EPS);
                }
            __builtin_amdgcn_sched_barrier(0);
        }
#pragma unroll
        for (int ai = 0; ai < 2; ++ai)
#pragma unroll
            for (int m = 0; m < 4; ++m) {
                const int rl = ai * HALF + wr * 64 + m * 16 + fr, r = rowb + rl;
                const float rstd = rs[ai][m];
#pragma unroll
                for (int bj = 0; bj < 2; ++bj) {
                    const int gidx = u.pn * 8 + bj * 4 + wc, head = gidx / 3, part = gidx - head * 3;
                    f32x4 x1 = acc[ai][bj][m][0] * rstd, x2 = acc[ai][bj][m][1] * rstd;
                    bf16_t* qrow = Q + (size_t)r * 1536 + head * 96;
                    if (part < 2) {
                        u32x4 o; o[0] = pk_bf16(x1[0], x1[1]); o[1] = pk_bf16(x1[2], x1[3]); o[2] = pk_bf16(x2[0], x2[1]); o[3] = pk_bf16(x2[2], x2[3]);
                        *(u32x4*)(qrow + part * 32 + 8 * fq) = o;
                    } else {
                        if (latent) {
                            const int s = s0 + rl, pos = (fq >> 1) ? (s & 63) : (s >> 6);
                            const LAS float* tp = tab + (pos * 8 + 4 * (fq & 1)) * 2;
                            const f32x4 t0 = *(const LAS f32x4*)tp, t1 = *(const LAS f32x4*)(tp + 4);
                            const f32x4 cs = {t0[0], t0[2], t1[0], t1[2]}, sn = {t0[1], t0[3], t1[1], t1[3]};
                            const f32x4 y1 = x1 * cs - x2 * sn, y2 = x2 * cs + x1 * sn; x1 = y1; x2 = y2;
                        }
                        bf16_t* dst = qrow + 64 + 16 * (fq >> 1) + 4 * (fq & 1);
                        u32x2 o1, o2; o1[0] = pk_bf16(x1[0], x1[1]); o1[1] = pk_bf16(x1[2], x1[3]); o2[0] = pk_bf16(x2[0], x2[1]); o2[1] = pk_bf16(x2[2], x2[3]);
                        *(u32x2*)dst = o1; *(u32x2*)(dst + 8) = o2;
                    }
                }
            }
    }
};
struct EpiUkv {
    bf16_t* Kd; bf16_t* Vt; const float* ssq;
    DI void operator()(const Acc& acc, const Unit& u, int wr, int wc, int fr, int fq) const {
        const int rowb = u.pm * BM; const bool latent = rowb < TL;
        const int b = latent ? (rowb >> 11) : ((rowb - TL) >> 8);
        const int kp0 = latent ? 256 + (rowb & 2047) : 0;
        float rs[2][4];
        {
            f32x4 qv[2][4];
            const int slot = fq < 2 ? fq : 0;
#pragma unroll
            for (int ai = 0; ai < 2; ++ai)
#pragma unroll
                for (int m = 0; m < 4; ++m) qv[ai][m] = *(const f32x4*)(ssq + (size_t)(rowb + ai * HALF + wr * 64 + m * 16 + fr) * 20 + 12 + slot * 4);
#pragma unroll
            for (int ai = 0; ai < 2; ++ai)
#pragma unroll
                for (int m = 0; m < 4; ++m) {
                    float t = fq < 2 ? (qv[ai][m][0] + qv[ai][m][1]) + (qv[ai][m][2] + qv[ai][m][3]) : 0.f;
                    t += shx(t, 16, 16 * fq + fr); t += shx(t, 32, 16 * fq + fr);
                    rs[ai][m] = rsqrtf(t * (1.f / 256.f) + LN_EPS);
                }
            __builtin_amdgcn_sched_barrier(0);
        }
#pragma unroll
        for (int ai = 0; ai < 2; ++ai)
#pragma unroll
            for (int m = 0; m < 4; ++m) {
                const int rl = ai * HALF + wr * 64 + m * 16 + fr, r = rowb + rl;
                const float rstd = rs[ai][m];
#pragma unroll
                for (int bj = 0; bj < 2; ++bj) {
                    const int head = u.pn * 2 + bj;
                    const f32x4 x1 = acc[ai][bj][m][0] * rstd, x2 = acc[ai][bj][m][1] * rstd;
                    if (wc < 2) {
                        u32x4 o; o[0] = pk_bf16(x1[0], x1[1]); o[1] = pk_bf16(x1[2], x1[3]); o[2] = pk_bf16(x2[0], x2[1]); o[3] = pk_bf16(x2[2], x2[3]);
                        *(u32x4*)(Kd + ((size_t)(b * 16 + head) * NKEY + kp0 + rl) * 64 + wc * 32 + 8 * fq) = o;
                    } else {
                        u32x4 o; o[0] = pk_bf16(x1[0], x1[1]); o[1] = pk_bf16(x1[2], x1[3]); o[2] = pk_bf16(x2[0], x2[1]); o[3] = pk_bf16(x2[2], x2[3]);
                        *(u32x4*)(Vt + ((size_t)(b * 16 + head) * NKEY + kp0 + rl) * 64 + (wc - 2) * 32 + 8 * fq) = o;
                    }
                }
            }
    }
};

DI float xmax32(float x) {
    const u32x2 r = __builtin_amdgcn_permlane32_swap(__builtin_bit_cast(unsigned, x), __builtin_bit_cast(unsigned, x), false, false);
    return fmaxf(__builtin_bit_cast(float, r[0]), __builtin_bit_cast(float, r[1]));
}
DI float xsum32(float x) {
    const u32x2 r = __builtin_amdgcn_permlane32_swap(__builtin_bit_cast(unsigned, x), __builtin_bit_cast(unsigned, x), false, false);
    return __builtin_bit_cast(float, r[0]) + __builtin_bit_cast(float, r[1]);
}
template <bool MLA>
DI void attn_phase(const int TID, const int BID, LAS unsigned char* lds, const Params& p, bool need_ctx) {
    constexpr int DK = MLA ? 96 : 64;
    constexpr int NKS = DK / 16;
    constexpr int KSTR = (DK + 8) * 2;
    constexpr int VSTR = 192;
    constexpr int KBUF = 64 * KSTR, VBUF = 64 * VSTR;
    constexpr int NKV = MLA ? 16 : 4;
    constexpr int QS = 16 * DK;
    const float sc = (MLA ? 0.10206207261596575f : 0.125f) * 1.4426950408889634f;
    const int tid = TID, wid = tid >> 6, lane = tid & 63, r = lane & 31, hh = lane >> 5;
    const int n_items = 1024 + (need_ctx ? 128 : 0);
    bf16_t* O = P_WSB(OFF_H);
    for (int item = BID; item < n_items; item += gridDim.x) {
        int b, head, row0, nk;
        if (item < 1024) {
            const int rnd = item >> 8, w = item & 255, xcd = w & 7, slot = w >> 3, qb = slot & 7;
            if (MLA) { const int grp = (rnd * 8 + xcd) * 4 + (slot >> 3); b = grp >> 4; head = grp & 15; }
            else { const int grp = rnd * 8 + xcd; b = grp >> 2; head = (grp & 3) * 4 + (slot >> 3); }
            row0 = b * 2048 + qb * 256; nk = NKEY;
        }
        else { const int it = item - 1024; b = it >> 4; head = it & 15; row0 = TL + b * 256; nk = 256; }
        const int kvh = MLA ? head : (head >> 2);
        const bf16_t* Kb = P_WSB(OFF_K) + (size_t)(b * NKV + kvh) * NKEY * 64;
        const bf16_t* Vb = P_WSB(OFF_VT) + (size_t)(b * NKV + kvh) * NKEY * 64;
        const bf16_t* Pb = P_WSB(OFF_KPE) + (size_t)b * NKEY * 32;
        bf16x8 qf[NKS];
        {
            const bf16_t* qp = P_WSB(OFF_Q) + (size_t)(row0 + wid * 32 + r) * QS + head * DK + hh * 8;
#pragma unroll
            for (int ks = 0; ks < NKS; ++ks) qf[ks] = *(const bf16x8*)(qp + ks * 16);
        }
        u32x4 kreg, vreg, preg = {0u, 0u, 0u, 0u};
#define AT_GLOADK(k0) do { kreg = *(const u32x4*)(Kb + (size_t)((k0) + (tid >> 3)) * 64 + (tid & 7) * 8); \
            if (MLA && tid < 256) preg = *(const u32x4*)(Pb + (size_t)((k0) + (tid >> 2)) * 32 + (tid & 3) * 8); } while (0)
#define AT_GLOADV(k0) do { vreg = *(const u32x4*)(Vb + (size_t)((k0) + (tid >> 3)) * 64 + (tid & 7) * 8); } while (0)
#define AT_WRITEK(buf) do { *(LAS u32x4*)(lds + (buf) * KBUF + (tid >> 3) * KSTR + (tid & 7) * 16) = kreg; \
            if (MLA && tid < 256) *(LAS u32x4*)(lds + (buf) * KBUF + (tid >> 2) * KSTR + 128 + (tid & 3) * 16) = preg; } while (0)
#define AT_WRITEV(buf) do { *(LAS u32x4*)(lds + 2 * KBUF + (buf) * VBUF + (tid >> 3) * VSTR + (tid & 7) * 16) = vreg; } while (0)
#define AT_QK(S0, S1, buf) do { const LAS unsigned char* kb = lds + (buf) * KBUF + r * KSTR + hh * 16; \
            _Pragma("unroll") for (int j = 0; j < 16; ++j) { S0[j] = 0.f; S1[j] = 0.f; } \
            _Pragma("unroll") for (int ks = 0; ks < NKS; ++ks) { \
                const bf16x8 a0 = *(const LAS bf16x8*)(kb + ks * 32); const bf16x8 a1 = *(const LAS bf16x8*)(kb + 32 * KSTR + ks * 32); \
                S0 = __builtin_amdgcn_mfma_f32_32x32x16_bf16(a0, qf[ks], S0, 0, 0, 0); S1 = __builtin_amdgcn_mfma_f32_32x32x16_bf16(a1, qf[ks], S1, 0, 0, 0); } } while (0)
#define AT_FMA(d, a_, b_, c_) do { float _a = (a_); asm("" : "+v"(_a)); d = __builtin_fmaf(_a, b_, c_); } while (0)
#define AT_ADD(d, a_, b_) do { d = (a_) + (b_); asm("" : "+v"(d)); } while (0)
#define AT_SMPV(S0, S1, buf) do { \
            float mx = fmaxf(fmaxf(S0[0], S0[1]), fmaxf(S1[0], S1[1])); \
            _Pragma("unroll") for (int j = 2; j < 16; j += 2) mx = fmaxf(mx, fmaxf(fmaxf(S0[j], S0[j + 1]), fmaxf(S1[j], S1[j + 1]))); \
            mx = xmax32(mx) * sc; \
            if (__builtin_amdgcn_ballot_w64(mx > mrun + 8.f) != 0ull) { \
                const float mnew = fmaxf(mrun, mx); const float alpha = __builtin_amdgcn_exp2f(mrun - mnew); mrun = mnew; lsum *= alpha; \
                _Pragma("unroll") for (int j = 0; j < 16; ++j) { o0[j] *= alpha; o1[j] *= alpha; } } \
            float psa = 0.f, psb = 0.f; const float nmr = -mrun; \
            _Pragma("unroll") for (int j = 0; j < 16; ++j) { \
                float e0, e1; AT_FMA(e0, S0[j], sc, nmr); AT_FMA(e1, S1[j], sc, nmr); \
                e0 = __builtin_amdgcn_exp2f(e0); e1 = __builtin_amdgcn_exp2f(e1); \
                AT_ADD(psa, psa, e0); AT_ADD(psb, psb, e1); S0[j] = e0; S1[j] = e1; } \
            lsum += psa + psb; \
            const LAS unsigned char* vb = lds + 2 * KBUF + (buf) * VBUF + (4 * hh + ((lane >> 2) & 3)) * VSTR + (16 * ((lane >> 4) & 1) + 4 * (lane & 3)) * 2; \
            _Pragma("unroll") for (int kt = 0; kt < 2; ++kt) _Pragma("unroll") for (int s = 0; s < 2; ++s) { \
                u32x4 pk; \
                if (kt == 0) { pk[0] = pk_bf16(S0[8 * s], S0[8 * s + 1]); pk[1] = pk_bf16(S0[8 * s + 2], S0[8 * s + 3]); pk[2] = pk_bf16(S0[8 * s + 4], S0[8 * s + 5]); pk[3] = pk_bf16(S0[8 * s + 6], S0[8 * s + 7]); } \
                else { pk[0] = pk_bf16(S1[8 * s], S1[8 * s + 1]); pk[1] = pk_bf16(S1[8 * s + 2], S1[8 * s + 3]); pk[2] = pk_bf16(S1[8 * s + 4], S1[8 * s + 5]); pk[3] = pk_bf16(S1[8 * s + 6], S1[8 * s + 7]); } \
                const bf16x8 pf = __builtin_bit_cast(bf16x8, pk); \
                const int koff = (kt * 32 + 16 * s) * VSTR; \
                const s16x4 l0 = __builtin_amdgcn_ds_read_tr16_b64_v4i16((LAS s16x4*)(vb + koff)), h0 = __builtin_amdgcn_ds_read_tr16_b64_v4i16((LAS s16x4*)(vb + koff + 8 * VSTR)); \
                const s16x4 l1 = __builtin_amdgcn_ds_read_tr16_b64_v4i16((LAS s16x4*)(vb + koff + 64)), h1 = __builtin_amdgcn_ds_read_tr16_b64_v4i16((LAS s16x4*)(vb + koff + 8 * VSTR + 64)); \
                const bf16x8 va0 = {l0[0], l0[1], l0[2], l0[3], h0[0], h0[1], h0[2], h0[3]}, va1 = {l1[0], l1[1], l1[2], l1[3], h1[0], h1[1], h1[2], h1[3]}; \
                o0 = __builtin_amdgcn_mfma_f32_32x32x16_bf16(va0, pf, o0, 0, 0, 0); \
                o1 = __builtin_amdgcn_mfma_f32_32x32x16_bf16(va1, pf, o1, 0, 0, 0); } } while (0)
#define AT_STEP(SC0, SC1, SN0, SN1, t, DOK, DOV) do { \
            if (DOK) AT_GLOADK(((t) + 2) * 64); \
            if (DOV) { AT_GLOADV(((t) + 1) * 64); AT_QK(SN0, SN1, ((t) + 1) & 1); } \
            AT_SMPV(SC0, SC1, (t) & 1); \
            if (DOK) AT_WRITEK((t) & 1); \
            if (DOV) AT_WRITEV(((t) + 1) & 1); \
            __syncthreads(); } while (0)
        f32x16 o0, o1, sa0, sa1, sb0, sb1;
#pragma unroll
        for (int j = 0; j < 16; ++j) { o0[j] = 0.f; o1[j] = 0.f; }
        float mrun = -1e30f, lsum = 0.f;
        if (wid >= 4) __builtin_amdgcn_s_setprio(1);
        const int ntile = nk >> 6;
        AT_GLOADK(0); AT_GLOADV(0); AT_WRITEK(0); AT_WRITEV(0);
        AT_GLOADK(64); AT_WRITEK(1);
        __syncthreads();
        AT_QK(sa0, sa1, 0);
        __syncthreads();
        int t = 0;
        for (; t < ntile - 2; t += 2) {
            AT_STEP(sa0, sa1, sb0, sb1, t, true, true);
            AT_STEP(sb0, sb1, sa0, sa1, t + 1, true, true);
        }
        AT_STEP(sa0, sa1, sb0, sb1, t, false, true);
        AT_STEP(sb0, sb1, sa0, sa1, t + 1, false, false);
        __builtin_amdgcn_s_setprio(0);
        lsum = xsum32(lsum);
        const float inv = 1.f / lsum;
        bf16_t* op = O + (size_t)(row0 + wid * 32 + r) * 1024 + head * 64 + 8 * hh;
#define AT_PK4(OX, jg) u32x2 { pk_bf16(OX[4 * (jg)] * inv, OX[4 * (jg) + 1] * inv), pk_bf16(OX[4 * (jg) + 2] * inv, OX[4 * (jg) + 3] * inv) }
#pragma unroll
        for (int k = 0; k < 2; ++k) {
            const u32x2 a = AT_PK4(o0, 2 * k), b2 = AT_PK4(o0, 2 * k + 1), c = AT_PK4(o1, 2 * k), d = AT_PK4(o1, 2 * k + 1);
            const u32x2 s0 = __builtin_amdgcn_permlane32_swap(a[0], b2[0], false, false), s1 = __builtin_amdgcn_permlane32_swap(a[1], b2[1], false, false);
            const u32x2 t0 = __builtin_amdgcn_permlane32_swap(c[0], d[0], false, false), t1 = __builtin_amdgcn_permlane32_swap(c[1], d[1], false, false);
            const u32x4 w0 = {s0[0], s1[0], s0[1], s1[1]}, w1 = {t0[0], t1[0], t0[1], t1[1]};
            *(u32x4*)(op + 16 * k) = w0; *(u32x4*)(op + 32 + 16 * k) = w1;
        }
#undef AT_PK4
#undef AT_GLOADK
#undef AT_GLOADV
#undef AT_WRITEK
#undef AT_WRITEV
#undef AT_QK
#undef AT_SMPV
#undef AT_FMA
#undef AT_ADD
#undef AT_STEP
    }
}

#define XB_TMO      128
#define XB_XCNT(j)  (256  + 64 * (j))
#define XB_XSUB(j)  (1280 + 64 * (j))
#define XB_XGEN(j)  (2304 + 64 * (j))
#define XB_TOP      3328
#define XB_TOPGEN   3392
#define XCD_BAR_WORDS 3456
#define XB_SPIN_CAP (1u << 18)
DI unsigned xb_ld(unsigned* p)              { return __hip_atomic_load(p, __ATOMIC_RELAXED, __HIP_MEMORY_SCOPE_AGENT); }
DI unsigned xb_add(unsigned* p, unsigned v) { return __hip_atomic_fetch_add(p, v, __ATOMIC_RELAXED, __HIP_MEMORY_SCOPE_AGENT); }
DI unsigned xb_xcc_id() { return (unsigned)__builtin_amdgcn_s_getreg((3 << 11) | 20) & 0xFu; }
#define XB_SPIN(cond, bar) do { unsigned _sp = 0; while (cond) { __builtin_amdgcn_s_sleep(1); \
    if ((++_sp & 255u) == 0u) { if (xb_ld(&(bar)[XB_TMO])) break; if (_sp > XB_SPIN_CAP) { atomicAdd(&(bar)[XB_TMO], 1u); break; } } } } while (0)
DI void xcd_barrier_complete(unsigned* bar, unsigned x, unsigned& nloc, unsigned& nx) {
    const unsigned G = gridDim.x;
    unsigned sum, cnt, mine, sp = 0u;
    for (;;) {
        sum = 0u; cnt = 0u; mine = 0u;
#pragma unroll
        for (unsigned j = 0; j < 16; ++j) { const unsigned c = xb_ld(&bar[XB_XCNT(j)]); sum += c; cnt += (c > 0u) ? 1u : 0u; mine = (j == x) ? c : mine; }
        if (sum == G) break;
        __builtin_amdgcn_s_sleep(1);
        if ((++sp & 255u) == 0u) { if (xb_ld(&bar[XB_TMO])) break; if (sp > XB_SPIN_CAP) { atomicAdd(&bar[XB_TMO], 1u); break; } }
    }
    nloc = mine > 0u ? mine : 1u; nx = cnt > 0u ? cnt : 1u;
}
DI void xcd_barrier(unsigned* bar, volatile LAS unsigned* st, const int tid) {
    asm volatile("s_waitcnt vmcnt(0)" ::: "memory");
    __syncthreads();
    if (tid == 0) {
        const unsigned x = xb_xcc_id();
        __builtin_amdgcn_s_waitcnt(0);
        unsigned nloc = st[0], nx = st[1];
        if (nloc == 0u) { xcd_barrier_complete(bar, x, nloc, nx); st[0] = nloc; st[1] = nx; }
        const unsigned old = xb_add(&bar[XB_XSUB(x)], 1u);
        const unsigned gen = old / nloc;
        if (old + 1u == (gen + 1u) * nloc) {
            __builtin_amdgcn_fence(__ATOMIC_RELEASE, "agent");
            asm volatile("s_waitcnt vmcnt(0)" ::: "memory");
            const unsigned og = xb_add(&bar[XB_TOP], 1u);
            const unsigned tg = og / nx;
            if (og + 1u == (tg + 1u) * nx) xb_add(&bar[XB_TOPGEN], 1u);
            else XB_SPIN(xb_ld(&bar[XB_TOPGEN]) == tg, bar);
            __builtin_amdgcn_fence(__ATOMIC_ACQUIRE, "agent");
            xb_add(&bar[XB_XGEN(x)], 1u);
            asm volatile("s_waitcnt vmcnt(0)" ::: "memory");
        } else {
            XB_SPIN(xb_ld(&bar[XB_XGEN(x)]) == gen, bar);
            __builtin_amdgcn_fence(__ATOMIC_ACQUIRE, "agent");
            asm volatile("s_waitcnt vmcnt(0)" ::: "memory");
        }
    }
    __syncthreads();
}

constexpr int NPHASE = 34;
__host__ __device__ inline bool phase_empty(int ph) { if (ph == 0 || ph == NPHASE - 1) return false; const int l = (ph - 1) >> 3, s = (ph - 1) & 7; return s == 2 && (l & 1) == 0; }

DI void run_phase(const int TID, const int BID, LAS unsigned char* lds, const Params& p, int ph) {
    if (ph == 0) { init_phase(TID, BID, lds, p); return; }
    if (ph == NPHASE - 1) { final_phase(TID, BID, p); return; }
    const int l = (ph - 1) >> 3, s = (ph - 1) & 7, j = l >> 1;
    const bool mla = l & 1;
    const int Mres = (l == 3) ? TL : TT;
    const float* modl = P_WSF(OFF_MOD) + (size_t)l * 9 * 6144;
    const LAS float* ropeG_l = (const LAS float*)(lds + LDS_ROPE);
    const LAS float* ropeM_l = (const LAS float*)(lds + LDS_ROPE + 8192);
    if (s == 1 || s == 2) {
        for (int i = TID; i < 3072; i += 512) ((LAS float*)(lds + LDS_ROPE))[i] = i < 2048 ? P_WSF(OFF_ROPEG)[i] : P_WSF(OFF_ROPEM)[i - 2048];
        __syncthreads();
    }
    switch (s) {
    case 0: prep_phase(TID, BID, p, l, 0, TT); break;
    case 1:
        if (!mla) { Gemm g{P_WSB(OFF_H), P_WSB(OFF_QKVT) + (size_t)j * 1536 * 1024, TT, 1536, 1024, 0}; EpiQkvG e{P_WSB(OFF_Q), P_WSB(OFF_K), P_WSB(OFF_VT), P_IN(11) + j * 64, P_IN(12) + j * 64, ropeG_l}; gemm_phase(TID, BID, lds, g, e); }
        else { Gemm g{P_WSB(OFF_H), P_WSB(OFF_WINT) + (size_t)j * 768 * 1024, TT, 768, 1024, 0}; EpiWin e{P_WSB(OFF_CQ), P_WSB(OFF_CKV), P_WSB(OFF_KPE), P_WSF(OFF_SSQ), ropeM_l}; gemm_phase(TID, BID, lds, g, e); }
        break;
    case 2:
        if (mla) {
            { Gemm g{P_WSB(OFF_CQ), P_WSB(OFF_WUQT) + (size_t)j * 1536 * 384, TT, 1536, 384, 0}; EpiUq e{P_WSB(OFF_Q), P_WSF(OFF_SSQ), ropeM_l}; gemm_phase(TID, BID, lds, g, e); }
            { Gemm g{P_WSB(OFF_CKV), P_WSB(OFF_WUKVT) + (size_t)j * 2048 * 256, TT, 2048, 256, 0}; EpiUkv e{P_WSB(OFF_K), P_WSB(OFF_VT), P_WSF(OFF_SSQ)}; gemm_phase(TID, BID, lds, g, e); }
        }
        break;
    case 3: if (mla) attn_phase<true>(TID, BID, lds, p, l < 3); else attn_phase<false>(TID, BID, lds, p, l < 3); break;
    case 4: {
        Gemm g{P_WSB(OFF_H), (mla ? P_WSB(OFF_WOMT) : P_WSB(OFF_WOGT)) + (size_t)j * 1024 * 1024, TL, 1024, 1024, l < 3 ? NSPLIT_WO : 0};
        if (l == 0) { EpiRes<true> e{P_WSB(OFF_Z), P_IN(0), P_IN(2), P_WSF(OFF_STATS), nullptr, nullptr, modl + 2048, P_WSB(OFF_PART)}; gemm_phase(TID, BID, lds, g, e); }
        else { EpiRes<false> e{P_WSB(OFF_Z), nullptr, nullptr, P_WSF(OFF_STATS), P_IN(6) + (l * 2 - 1) * 1024, P_IN(7) + (l * 2 - 1) * 1024, modl + 2048, P_WSB(OFF_PART)}; gemm_phase(TID, BID, lds, g, e); }
        break; }
    case 5: prep_phase(TID, BID, p, l, 1, Mres); break;
    case 6: { Gemm g{P_WSB(OFF_H), P_WSB(OFF_W1T) + (size_t)l * 4096 * 1024, Mres, 4096, 1024, 0}; EpiMlp1 e{P_WSB(OFF_U)}; gemm_phase(TID, BID, lds, g, e); break; }
    case 7: { Gemm g{P_WSB(OFF_U), P_WSB(OFF_W2T) + (size_t)l * 1024 * 4096, TL, 1024, 4096, l < 3 ? NSPLIT_M2 : 0}; EpiRes<false> e{P_WSB(OFF_Z), nullptr, nullptr, P_WSF(OFF_STATS), P_IN(6) + (l * 2) * 1024, P_IN(7) + (l * 2) * 1024, modl + 5120, P_WSB(OFF_PART)}; gemm_phase(TID, BID, lds, g, e); break; }
    }
}

__global__ void __launch_bounds__(512) mega(Params p, int ph_lo, int ph_hi) {
    extern __shared__ __attribute__((aligned(16))) unsigned char shm[];
    cg::grid_group grid = cg::this_grid();
    volatile LAS unsigned* st = (volatile LAS unsigned*)((LAS unsigned char*)shm + LDS_STAGE);
    unsigned* bar = (unsigned*)(GAS unsigned*)(p.ws + OFF_BAR);
    if (threadIdx.x == 0) { st[0] = 0u; st[1] = 0u; (void)xb_add(&bar[XB_XCNT(xb_xcc_id())], 1u); }
    __syncthreads();
    if (ph_lo < -1000) grid.sync();
    bool first = true, dup = false;
    for (int ph = ph_lo; ph < ph_hi; ++ph) {
        if (phase_empty(ph)) continue;
        int tid = threadIdx.x, bid = blockIdx.x; unsigned lbase = 0;
        asm volatile("" : "+v"(tid), "+s"(bid), "+s"(lbase));
        if (!first) xcd_barrier(bar, st, tid);
        first = false;
        run_phase(tid, bid, (LAS unsigned char*)shm + lbase, p, ph);
#ifdef PROBE_DUP
        if ((ph == 0 ? ((PROBE_DUP >> 8) & 1) : (ph < NPHASE - 1 && ((PROBE_DUP >> ((ph - 1) & 7)) & 1))) && !dup) { dup = true; --ph; } else dup = false;
#endif
    }
}

extern "C" void kernel_launch(void* const* d_in, const int* in_sizes, int n_in, void* d_out, int out_size, void* d_ws, size_t ws_size, hipStream_t stream) {
    static int grid_blocks = 0;
    if (!grid_blocks) {
        int dev = 0, cus = 0, per_cu = 0;
        hipGetDevice(&dev);
        hipDeviceGetAttribute(&cus, hipDeviceAttributeMultiprocessorCount, dev);
        hipFuncSetAttribute((const void*)mega, hipFuncAttributeMaxDynamicSharedMemorySize, LDS_BYTES);
        hipOccupancyMaxActiveBlocksPerMultiprocessor(&per_cu, mega, 512, LDS_BYTES);
        if (per_cu < 1) per_cu = 1;
        grid_blocks = cus * per_cu;
    }
    Params p{};
    for (int i = 0; i < 20; ++i) p.in[i] = (const float*)d_in[i];
    p.out = (float*)d_out; p.ws = (unsigned char*)d_ws;
    if (WS_NEED > ws_size) { fprintf(stderr, "workspace too small: need %zu have %zu\n", (size_t)WS_NEED, ws_size); return; }
    hipMemsetAsync(d_ws, 0, BAR_BYTES, stream);
#if MK_SINGLE
    int lo = 0, hi = NPHASE;
    void* args[] = {&p, &lo, &hi};
    hipError_t e = hipLaunchCooperativeKernel((const void*)mega, dim3(grid_blocks), dim3(512), args, LDS_BYTES, stream);
    if (e != hipSuccess) fprintf(stderr, "cooperative launch failed: %s (grid %d)\n", hipGetErrorString(e), grid_blocks);
#else
    for (int ph = 0; ph < NPHASE; ++ph) {
        if (phase_empty(ph)) continue;
        mega<<<dim3(grid_blocks), dim3(512), LDS_BYTES, stream>>>(p, ph, ph + 1);
    }
#endif
}
```

```cpp
#include <hip/hip_runtime.h>
#include <hip/hip_cooperative_groups.h>
#include <cstdio>
namespace cg = cooperative_groups;

#ifndef MK_SINGLE
#define MK_SINGLE 1
#endif

#define DI __device__ __forceinline__
#define LAS __attribute__((address_space(3)))
typedef unsigned short bf16_t;
typedef short bf16x8 __attribute__((ext_vector_type(8)));
typedef float f32x4 __attribute__((ext_vector_type(4)));
typedef float f32x2 __attribute__((ext_vector_type(2)));
typedef float f32x16 __attribute__((ext_vector_type(16)));
typedef unsigned u32x4 __attribute__((ext_vector_type(4)));
typedef unsigned u32x2 __attribute__((ext_vector_type(2)));
typedef __bf16 bf2_t __attribute__((ext_vector_type(2)));
typedef short s16x4 __attribute__((ext_vector_type(4)));

constexpr int TL = 16384, TC = 2048, TT = 18432, DM = 1024, NKEY = 2304;
constexpr float LN_EPS = 1e-6f;
constexpr float ALPHA = 1.681792830507429f;
constexpr int LDS_STAGE = 131072;
constexpr int LDS_ROPE = LDS_STAGE + 64;
constexpr int LDS_BYTES = LDS_ROPE + 8192 + 4096;

constexpr size_t al256(size_t x) { return (x + 255) & ~(size_t)255; }
constexpr size_t OFF_BAR = 0;
constexpr size_t BAR_BYTES = 16384;
constexpr size_t OFF_MOD = OFF_BAR + BAR_BYTES;
constexpr size_t OFF_ROPEG = OFF_MOD + al256((size_t)4 * 9 * 6144 * 4);
constexpr size_t OFF_ROPEM = OFF_ROPEG + al256(64 * 16 * 2 * 4);
constexpr size_t OFF_STATS = OFF_ROPEM + al256(64 * 8 * 2 * 4);
constexpr size_t OFF_SSQ = OFF_STATS + al256((size_t)TT * 2 * 4);
constexpr size_t OFF_Z = OFF_SSQ + al256((size_t)TT * 20 * 4);
constexpr size_t OFF_W1T = OFF_Z + al256((size_t)TT * 1024 * 2);
constexpr size_t OFF_W2T = OFF_W1T + al256((size_t)4 * 4096 * 1024 * 2);
constexpr size_t OFF_QKVT = OFF_W2T + al256((size_t)4 * 4096 * 1024 * 2);
constexpr size_t OFF_WOGT = OFF_QKVT + al256((size_t)2 * 1536 * 1024 * 2);
constexpr size_t OFF_WINT = OFF_WOGT + al256((size_t)2 * 1024 * 1024 * 2);
constexpr size_t OFF_WUQT = OFF_WINT + al256((size_t)2 * 768 * 1024 * 2);
constexpr size_t OFF_WUKVT = OFF_WUQT + al256((size_t)2 * 1536 * 384 * 2);
constexpr size_t OFF_WOMT = OFF_WUKVT + al256((size_t)2 * 2048 * 256 * 2);
constexpr size_t OFF_H = OFF_WOMT + al256((size_t)2 * 1024 * 1024 * 2);
constexpr size_t OFF_R1 = OFF_H + al256((size_t)TT * 1024 * 2);
constexpr size_t OFF_Q = OFF_R1;
constexpr size_t OFF_K = OFF_Q + al256((size_t)TT * 1536 * 2);
constexpr size_t OFF_KPE = OFF_K + al256((size_t)8 * 16 * NKEY * 64 * 2);
constexpr size_t OFF_VT = OFF_KPE + al256((size_t)8 * NKEY * 32 * 2);
constexpr size_t OFF_CQ = OFF_VT + al256((size_t)8 * 16 * 64 * NKEY * 2);
constexpr size_t OFF_CKV = OFF_CQ + al256((size_t)TT * 384 * 2);
constexpr size_t END_MIX = OFF_CKV + al256((size_t)TT * 256 * 2);
constexpr size_t OFF_U = OFF_R1;
constexpr size_t END_U = OFF_U + al256((size_t)TT * 4096 * 2);
constexpr size_t OFF_PART = END_MIX > END_U ? END_MIX : END_U;
constexpr size_t WS_NEED = OFF_PART + al256((size_t)8 * TC * 1024 * 2);
static_assert(WS_NEED <= (size_t)402653184, "workspace budget");
constexpr int NSPLIT_WO = 4, NSPLIT_M2 = 8;

struct Params { const float* in[20]; float* out; unsigned char* ws; };
#define GAS __attribute__((address_space(1)))
#define P_IN(i) ((const float*)(GAS const float*)(p.in[i]))
#define P_WSF(off) ((float*)(GAS float*)(p.ws + (off)))
#define P_WSB(off) ((bf16_t*)(GAS bf16_t*)(p.ws + (off)))
#define P_OUT ((float*)(GAS float*)(p.out))


DI unsigned pk_bf16(float lo, float hi) {
    f32x2 v = {lo, hi};
    bf2_t r = __builtin_convertvector(v, bf2_t);
    return __builtin_bit_cast(unsigned, r);
}
DI f32x4 unpk4(u32x2 v) { f32x4 r; r[0] = __builtin_bit_cast(float, v[0] << 16); r[1] = __builtin_bit_cast(float, v[0] & 0xffff0000u); r[2] = __builtin_bit_cast(float, v[1] << 16); r[3] = __builtin_bit_cast(float, v[1] & 0xffff0000u); return r; }
DI bf16_t to_bf16(float f) { return (bf16_t)(pk_bf16(f, 0.f) & 0xffffu); }
DI float shx(float v, int m, int lane) { return __builtin_bit_cast(float, __builtin_amdgcn_ds_bpermute((lane ^ m) << 2, __builtin_bit_cast(int, v))); }
DI float wave_sum(float v, int lane) {
#pragma unroll
    for (int o = 32; o >= 1; o >>= 1) v += shx(v, o, lane);
    return v;
}

DI int perm32(int rho) { const int n = rho >> 4, i = rho & 15; return 8 * (i >> 2) + 4 * n + (i & 3); }
DI int rope32(int rho) { const int n = rho >> 4, fq = (rho >> 2) & 3, j = rho & 3; return 16 * (fq >> 1) + 4 * (fq & 1) + 8 * n + j; }
enum { MODE_NAT = 0, MODE_P8 = 1, MODE_GQA = 2, MODE_WIN = 3, MODE_UQ = 4, MODE_P8W = 5 };
DI int srccol(int mode, int nidx) {
    const int rho = nidx & 31;
    if (mode == MODE_NAT) return nidx;
    if (mode == MODE_P8) return (nidx & ~31) + perm32(rho);
    if (mode == MODE_P8W) { const int tc = nidx & 255, bj = tc >> 7, wc = (tc >> 5) & 3; return (nidx & ~255) + 64 * wc + 32 * bj + perm32(rho); }
    if (mode == MODE_GQA) {
        const int tile = nidx >> 8, tc = nidx & 255, bj = tc >> 7, wc = (tc >> 5) & 3, n = rho >> 4, fq = (rho >> 2) & 3, j = rho & 3;
        return 64 * (4 * tile + wc) + 32 * (fq >> 1) + 8 * (fq & 1) + 16 * bj + 4 * n + j;
    }
    if (mode == MODE_WIN) {
        if (nidx < 640) return (nidx & ~31) + perm32(rho);
        if (nidx < 672) return 640 + rope32(rho);
        return -1;
    }
    { const int part = (nidx >> 5) % 3; return (nidx & ~31) + (part == 2 ? rope32(rho) : perm32(rho)); }
}

DI void transpose_job(const int TID, const int BID, LAS unsigned char* lds, const float* W, int K, int Nsrc, int Npad, bf16_t* Bt, int mode, const float* kscale) {
    const int tid = TID;
    const int nkt = K >> 6, ntile = (Npad >> 6) * nkt;
    LAS unsigned* tl = (LAS unsigned*)lds;
    const int kp = tid >> 4, dq = tid & 15;
    for (int t = BID; t < ntile; t += gridDim.x) {
        const int n0 = (t / nkt) << 6, k0 = (t % nkt) << 6;
        const int sc = srccol(mode, n0 + 4 * dq);
        f32x4 va = {0.f, 0.f, 0.f, 0.f}, vb = va;
        if (sc >= 0) {
            va = *(const f32x4*)(W + (size_t)(k0 + 2 * kp) * Nsrc + sc); vb = *(const f32x4*)(W + (size_t)(k0 + 2 * kp + 1) * Nsrc + sc);
            if (kscale) { va *= kscale[k0 + 2 * kp]; vb *= kscale[k0 + 2 * kp + 1]; }
        }
#pragma unroll
        for (int e = 0; e < 4; ++e) tl[(4 * dq + e) * 33 + kp] = pk_bf16(va[e], vb[e]);
        __syncthreads();
        {
            const int n2 = tid >> 3, c2 = tid & 7;
            u32x4 o;
#pragma unroll
            for (int i = 0; i < 4; ++i) o[i] = tl[n2 * 33 + c2 * 4 + i];
            *(u32x4*)(Bt + (size_t)(n0 + n2) * K + k0 + c2 * 8) = o;
        }
        __syncthreads();
    }
}

DI void init_phase(const int TID, const int BID, LAS unsigned char* lds, const Params& p) {
    const int tid = TID;
    {
        const int i = BID * 512 + tid;
        if (i < 1024) { const int pos = i >> 4, f = i & 15; const float inv = powf(10000.f, -(float)f / 16.f); const float a = (float)pos * inv; P_WSF(OFF_ROPEG)[2 * i] = cosf(a); P_WSF(OFF_ROPEG)[2 * i + 1] = sinf(a); }
        else if (i < 1536) { const int i2 = i - 1024; const int pos = i2 >> 3, f = i2 & 7; const float inv = powf(10000.f, -(float)f / 8.f); const float a = (float)pos * inv; P_WSF(OFF_ROPEM)[2 * i2] = cosf(a); P_WSF(OFF_ROPEM)[2 * i2 + 1] = sinf(a); }
    }
    {
        LAS float* sl = (LAS float*)lds;
        LAS float* part = sl + 9216;
        for (int i = tid; i < 9216; i += 512) { const int j = i >> 10, k = i & 1023; const float cv = j < 8 ? P_IN(1)[j * 1024 + k] : P_IN(3)[k]; sl[i] = cv / (1.f + expf(-cv)); }
        __syncthreads();
        for (int item = BID; item < 384; item += gridDim.x) {
            const int l = item / 96, n0 = (item % 96) * 64, kg = tid >> 4, c4 = (tid & 15) * 4;
            const float* w = P_IN(4) + ((size_t)l * 1024 + kg * 32) * 6144 + n0 + c4;
            f32x4 acc9[9];
#pragma unroll
            for (int j = 0; j < 9; ++j) acc9[j] = (f32x4){0.f, 0.f, 0.f, 0.f};
#pragma unroll 8
            for (int k = 0; k < 32; ++k) {
                const f32x4 wv = *(const f32x4*)(w + (size_t)k * 6144);
                const LAS float* sp = sl + kg * 32 + k;
#pragma unroll
                for (int j = 0; j < 9; ++j) acc9[j] += wv * sp[j * 1024];
            }
#pragma unroll
            for (int j = 0; j < 9; ++j) *(LAS f32x4*)(part + (kg * 9 + j) * 64 + c4) = acc9[j];
            __syncthreads();
            for (int i = tid; i < 576; i += 512) {
                const int j = i >> 6, c2 = i & 63;
                float sum = 0.f;
#pragma unroll 8
                for (int g = 0; g < 32; ++g) sum += part[g * 576 + i];
                P_WSF(OFF_MOD)[(size_t)(l * 9 + j) * 6144 + n0 + c2] = sum + P_IN(5)[l * 6144 + n0 + c2];
            }
            __syncthreads();
        }
    }
    for (int l = 0; l < 4; ++l) transpose_job(TID, BID, lds, P_IN(8) + (size_t)l * 1024 * 4096, 1024, 4096, 4096, P_WSB(OFF_W1T) + (size_t)l * 4096 * 1024, MODE_P8W, nullptr);
    for (int l = 0; l < 4; ++l) transpose_job(TID, BID, lds, P_IN(9) + (size_t)l * 4096 * 1024, 4096, 1024, 1024, P_WSB(OFF_W2T) + (size_t)l * 1024 * 4096, MODE_P8, nullptr);
    for (int j = 0; j < 2; ++j) {
        transpose_job(TID, BID, lds, P_IN(10) + (size_t)j * 1024 * 1536, 1024, 1536, 1536, P_WSB(OFF_QKVT) + (size_t)j * 1536 * 1024, MODE_GQA, nullptr);
        transpose_job(TID, BID, lds, P_IN(13) + (size_t)j * 1024 * 1024, 1024, 1024, 1024, P_WSB(OFF_WOGT) + (size_t)j * 1024 * 1024, MODE_P8, nullptr);
        transpose_job(TID, BID, lds, P_IN(14) + (size_t)j * 1024 * 672, 1024, 672, 768, P_WSB(OFF_WINT) + (size_t)j * 768 * 1024, MODE_WIN, nullptr);
        transpose_job(TID, BID, lds, P_IN(17) + (size_t)j * 384 * 1536, 384, 1536, 1536, P_WSB(OFF_WUQT) + (size_t)j * 1536 * 384, MODE_UQ, P_IN(15) + j * 384);
        transpose_job(TID, BID, lds, P_IN(18) + (size_t)j * 256 * 2048, 256, 2048, 2048, P_WSB(OFF_WUKVT) + (size_t)j * 2048 * 256, MODE_P8, P_IN(16) + j * 256);
        transpose_job(TID, BID, lds, P_IN(19) + (size_t)j * 1024 * 1024, 1024, 1024, 1024, P_WSB(OFF_WOMT) + (size_t)j * 1024 * 1024, MODE_P8, nullptr);
    }
}

template <int PR>
#define PCOL(i) ((((i) >> 1) << 9) + lane * 8 + (((i) & 1) << 2))
DI void prep_rows(const int lane, const Params& p, int l, int which, int rbeg, int rend, int gw, int nw) {
    for (int row = rbeg + gw * PR; row < rend; row += nw * PR) {
        const int mi = row < TL ? (row >> 11) : 8;
        const bool raw = (which == 0 && l == 0);
        f32x4 v[PR][4];
#pragma unroll
        for (int rr = 0; rr < PR; ++rr) {
            const int r2 = row + rr;
            if (raw) {
                const float* src = r2 < TL ? P_IN(0) + (size_t)r2 * 1024 : P_IN(2) + (size_t)(r2 - TL) * 1024;
#pragma unroll
                for (int i = 0; i < 4; ++i) v[rr][i] = *(const f32x4*)(src + PCOL(i));
            } else {
                const bf16_t* src = P_WSB(OFF_Z) + (size_t)r2 * 1024;
#pragma unroll
                for (int i = 0; i < 4; i += 2) { const u32x4 zz = *(const u32x4*)(src + PCOL(i)); const u32x2 zl = {zz[0], zz[1]}, zh = {zz[2], zz[3]}; v[rr][i] = unpk4(zl); v[rr][i + 1] = unpk4(zh); }
            }
        }
        if (row >= TL && !raw) {
            const bool rawres = (which == 1 && l == 0);
            const int lp = which ? l : l - 1;
            const float* gp = P_WSF(OFF_MOD) + (size_t)(lp * 9 + 8) * 6144 + (which ? 2048 : 5120);
            if (rawres) {
#pragma unroll
                for (int rr = 0; rr < PR; ++rr) {
                    const float* cs = P_IN(2) + (size_t)(row + rr - TL) * 1024;
#pragma unroll
                    for (int i = 0; i < 4; ++i) v[rr][i] = *(const f32x4*)(cs + PCOL(i));
                }
            } else {
                const int lj = which ? (l * 2 - 1) : (l * 2 - 2);
                const float* lg2 = P_IN(6) + lj * 1024; const float* lb2 = P_IN(7) + lj * 1024;
#pragma unroll
                for (int i = 0; i < 4; ++i) {
                    const f32x4 g = *(const f32x4*)(lg2 + PCOL(i)), b = *(const f32x4*)(lb2 + PCOL(i));
#pragma unroll
                    for (int rr = 0; rr < PR; ++rr) { const f32x2 st = *(const f32x2*)(P_WSF(OFF_STATS) + 2 * (row + rr)); v[rr][i] = (v[rr][i] - st[0]) * st[1] * g + b; }
                }
            }
#pragma unroll
            for (int i = 0; i < 4; ++i) {
                const int c = PCOL(i);
                const f32x4 gv = *(const f32x4*)(gp + c);
#pragma unroll
                for (int rr = 0; rr < PR; ++rr) {
                    const bf16_t* pp = P_WSB(OFF_PART) + (size_t)(row + rr - TL) * 1024 + c;
                    f32x4 a = unpk4(*(const u32x2*)pp);
#pragma unroll
                    for (int k = 1; k < NSPLIT_WO; ++k) a += unpk4(*(const u32x2*)(pp + (size_t)k * TC * 1024));
                    if (which == 0) {
#pragma unroll
                        for (int k = NSPLIT_WO; k < NSPLIT_M2; ++k) a += unpk4(*(const u32x2*)(pp + (size_t)k * TC * 1024));
                    }
                    v[rr][i] = v[rr][i] * ALPHA + gv * a;
                    { u32x2 zo; zo[0] = pk_bf16(v[rr][i][0], v[rr][i][1]); zo[1] = pk_bf16(v[rr][i][2], v[rr][i][3]); *(u32x2*)(P_WSB(OFF_Z) + (size_t)(row + rr) * 1024 + c) = zo; v[rr][i] = unpk4(zo); }
                }
            }
        }
        if (!raw) {
            const int li = which == 2 ? 7 : (which ? (l * 2) : (l * 2 - 1));
            const float* lg = P_IN(6) + li * 1024; const float* lb = P_IN(7) + li * 1024;
            float sm[PR], sq[PR];
#pragma unroll
            for (int rr = 0; rr < PR; ++rr) { float s = 0.f;
#pragma unroll
                for (int i = 0; i < 4; ++i) s += v[rr][i][0] + v[rr][i][1] + v[rr][i][2] + v[rr][i][3];
                sm[rr] = s; }
#pragma unroll
            for (int o = 32; o >= 1; o >>= 1)
#pragma unroll
                for (int rr = 0; rr < PR; ++rr) sm[rr] += shx(sm[rr], o, lane);
#pragma unroll
            for (int rr = 0; rr < PR; ++rr) { const float mean = sm[rr] * (1.f / 1024.f); sm[rr] = mean; float q = 0.f;
#pragma unroll
                for (int i = 0; i < 4; ++i) { v[rr][i] -= mean; q += v[rr][i][0] * v[rr][i][0] + v[rr][i][1] * v[rr][i][1] + v[rr][i][2] * v[rr][i][2] + v[rr][i][3] * v[rr][i][3]; }
                sq[rr] = q; }
#pragma unroll
            for (int o = 32; o >= 1; o >>= 1)
#pragma unroll
                for (int rr = 0; rr < PR; ++rr) sq[rr] += shx(sq[rr], o, lane);
#pragma unroll
            for (int rr = 0; rr < PR; ++rr) { sq[rr] = rsqrtf(sq[rr] * (1.f / 1024.f) + LN_EPS);
                if (which != 2 && lane == 0) { P_WSF(OFF_STATS)[2 * (row + rr)] = sm[rr]; P_WSF(OFF_STATS)[2 * (row + rr) + 1] = sq[rr]; } }
#pragma unroll
            for (int i = 0; i < 4; ++i) { const f32x4 g = *(const f32x4*)(lg + PCOL(i)), b = *(const f32x4*)(lb + PCOL(i));
#pragma unroll
                for (int rr = 0; rr < PR; ++rr) v[rr][i] = v[rr][i] * sq[rr] * g + b; }
        }
        if (which == 2) {
#pragma unroll
            for (int rr = 0; rr < PR; ++rr)
#pragma unroll
                for (int i = 0; i < 4; ++i) *(f32x4*)(P_OUT + (size_t)(row + rr) * 1024 + PCOL(i)) = v[rr][i];
        } else {
            const float* modp = P_WSF(OFF_MOD) + (size_t)(l * 9 + mi) * 6144 + (which ? 3072 : 0);
#pragma unroll
            for (int i = 0; i < 4; i += 2) {
                const f32x4 sh0 = *(const f32x4*)(modp + PCOL(i)), sc0 = *(const f32x4*)(modp + 1024 + PCOL(i));
                const f32x4 sh1 = *(const f32x4*)(modp + PCOL(i + 1)), sc1 = *(const f32x4*)(modp + 1024 + PCOL(i + 1));
#pragma unroll
                for (int rr = 0; rr < PR; ++rr) {
                    const f32x4 h0 = v[rr][i] * (sc0 + 1.f) + sh0, h1 = v[rr][i + 1] * (sc1 + 1.f) + sh1;
                    u32x4 o; o[0] = pk_bf16(h0[0], h0[1]); o[1] = pk_bf16(h0[2], h0[3]); o[2] = pk_bf16(h1[0], h1[1]); o[3] = pk_bf16(h1[2], h1[3]);
                    *(u32x4*)(P_WSB(OFF_H) + (size_t)(row + rr) * 1024 + PCOL(i)) = o;
                }
            }
        }
    }
}
DI void prep_phase(const int TID, const int BID, const Params& p, int l, int which, int M) {
    if (M > TL) prep_rows<1>(TID & 63, p, l, which, TL, M, BID * 8 + (TID >> 6), gridDim.x * 8);
    prep_rows<4>(TID & 63, p, l, which, 0, TL, BID * 8 + (TID >> 6), gridDim.x * 8);
}
DI void final_phase(const int TID, const int BID, const Params& p) {
    prep_rows<4>(TID & 63, p, 3, 2, 0, TL, BID * 8 + (TID >> 6), gridDim.x * 8);
}

constexpr int BM = 256, BK = 64, HALF = 128, HTB = HALF * BK * 2, NXCD = 8, WGM = 8;
DI int lds_byte(int r, int c) { const int st = (r >> 4) * 2 + (c >> 5), rr = r & 15, cc = c & 31, ob = rr * 64 + cc * 2; return st * 1024 + (ob ^ (((ob >> 9) & 1) << 5)); }
DI void stage_rc(int b, int& R, int& C) { const int st = b / 1024, sb = b % 1024, swz = sb ^ (((sb >> 9) & 1) << 5); R = (st >> 1) * 16 + swz / 64; C = (st & 1) * 32 + (swz % 64) / 2; }
struct Unit { int pm, pn, k0, nt, ks; };
struct Gemm { const bf16_t* A; const bf16_t* Bt; int M, N, K; int nsplit; };
struct StaticOrder {
    int nM, nN, nwg, G, c, K, S;
    DI void init(int M, int N, int K_, int S_, int G_, int c_) { nM = M / BM; nN = N / BM; nwg = nM * nN; G = G_; c = c_; K = K_; S = S_; }
    DI bool next(int i, Unit& u) const {
        const long L = (long)i * G + c;
        u.pm = 0; u.pn = 0; u.k0 = 0; u.nt = K / BK; u.ks = -1;
        if (L >= nwg) {
            const int e = (int)(L - nwg);
            if (e >= 8 * nN * S) return false;
            const int tile = e / S;
            u.ks = e - tile * S; u.pm = TL / BM + (tile & 7); u.pn = tile >> 3; u.nt = K / (BK * S); u.k0 = u.ks * (K / S);
            return true;
        }
        int wgid = (int)L; { const int q = nwg / NXCD, r = nwg % NXCD, xcd = wgid % NXCD, off = wgid / NXCD; wgid = (xcd < r ? xcd * (q + 1) : r * (q + 1) + (xcd - r) * q) + off; }
        const int nig = WGM * nN, gid = wgid / nig, fm = gid * WGM, gsz = (nM - fm) < WGM ? (nM - fm) : WGM;
        u.pm = fm + ((wgid % nig) % gsz); u.pn = (wgid % nig) / gsz; u.k0 = 0; u.nt = K / BK; u.ks = -1; return true;
    }
};
template <class Epi>
DI void gemm_phase(const int TID, const int BID, LAS unsigned char* lds, const Gemm g, const Epi& E) {
    const int tid = TID, wid = __builtin_amdgcn_readfirstlane(tid >> 6), lane = tid & 63, wr = wid >> 2, wc = wid & 3, fr = lane & 15, fq = lane >> 4;
    int K = g.K; asm volatile("" : "+s"(K));
    StaticOrder S; S.init(g.M, g.N, K, g.nsplit, (int)gridDim.x, BID);
    unsigned voffA[2];
#pragma unroll
    for (int i = 0; i < 2; ++i) { int R, C; stage_rc(tid * 16 + i * 8192, R, C); voffA[i] = (unsigned)(R * K + C) * 2u; }
    const size_t kstep = (size_t)(BK * 2);
    const size_t hstep = (size_t)HALF * K * 2;
    const size_t tstep = 2 * hstep;
    const unsigned ldsw = (unsigned)wid * 1024u;
    const int aoff = lds_byte(wr * 64 + fr, fq * 8), boff = lds_byte(wc * 32 + fr, fq * 8);
#define PG8_SA(b, h) (((b) * 2 + (h)) * HTB)
#define PG8_SB(b, h) ((4 + (b) * 2 + (h)) * HTB)
#define PG8_STAGE(bufoff, gbase) do { _Pragma("unroll") for (int _i = 0; _i < 2; ++_i) \
        __builtin_amdgcn_global_load_lds((const unsigned*)((const char*)(gbase) + voffA[_i]), (LAS unsigned*)(lds + (bufoff) + ldsw + _i * 8192), 16, 0, 0); } while (0)
#define PG8_LDA(dst, b, h) do { _Pragma("unroll") for (int m = 0; m < 4; ++m) _Pragma("unroll") for (int k = 0; k < 2; ++k) dst[m][k] = *(const LAS bf16x8*)(lds + PG8_SA(b, h) + aoff + m * 2048 + k * 1024); } while (0)
#define PG8_LDB(dst, b, h) do { _Pragma("unroll") for (int n = 0; n < 2; ++n) _Pragma("unroll") for (int k = 0; k < 2; ++k) dst[n][k] = *(const LAS bf16x8*)(lds + PG8_SB(b, h) + boff + n * 2048 + k * 1024); } while (0)
#define PG8_MMA(ai, bj, At, Bt) do { __builtin_amdgcn_s_setprio(1); _Pragma("unroll") for (int m = 0; m < 4; ++m) _Pragma("unroll") for (int n = 0; n < 2; ++n) _Pragma("unroll") for (int k = 0; k < 2; ++k) \
        acc[ai][bj][m][n] = __builtin_amdgcn_mfma_f32_16x16x32_bf16(Bt[n][k], At[m][k], acc[ai][bj][m][n], 0, 0, 0); __builtin_amdgcn_s_setprio(0); } while (0)
#define PG8_WAIT_V(n) asm volatile("s_waitcnt vmcnt(" #n ")" ::: "memory")
#define PG8_WAIT_L(n) asm volatile("s_waitcnt lgkmcnt(" #n ")" ::: "memory")
#define PG8_BAR __builtin_amdgcn_s_barrier()
#define PG8_SCHED __builtin_amdgcn_sched_barrier(0)
    Unit cur, nxt; int ui = 0;
    if (!S.next(0, cur)) return;
    f32x4 acc[2][2][4][2];
#pragma unroll
    for (int a = 0; a < 2; ++a)
#pragma unroll
        for (int b = 0; b < 2; ++b)
#pragma unroll
            for (int m = 0; m < 4; ++m)
#pragma unroll
                for (int n = 0; n < 2; ++n) acc[a][b][m][n] = (f32x4){0.f, 0.f, 0.f, 0.f};
    bf16x8 At[4][2], B0[2][2], B1[2][2];
    const char* cA = (const char*)g.A + (size_t)cur.pm * tstep + (size_t)cur.k0 * 2; const char* cB = (const char*)g.Bt + (size_t)cur.pn * tstep + (size_t)cur.k0 * 2;
    PG8_STAGE(PG8_SB(0, 0), cB); PG8_STAGE(PG8_SA(0, 0), cA); PG8_STAGE(PG8_SB(0, 1), cB + hstep); PG8_STAGE(PG8_SA(0, 1), cA + hstep);
    if (wr == 1) PG8_BAR;
    PG8_WAIT_V(4); PG8_BAR;
    PG8_STAGE(PG8_SB(1, 0), cB + kstep); PG8_STAGE(PG8_SA(1, 0), cA + kstep); PG8_STAGE(PG8_SB(1, 1), cB + hstep + kstep);
    PG8_WAIT_V(6); PG8_BAR;
    for (;;) {
        const bool has_next = S.next(ui + 1, nxt);
        const char* nA = has_next ? (const char*)g.A + (size_t)nxt.pm * tstep + (size_t)nxt.k0 * 2 : cA; const char* nB = has_next ? (const char*)g.Bt + (size_t)nxt.pn * tstep + (size_t)nxt.k0 * 2 : cB;
        const int nt = cur.nt;
        for (int t = 0; t < nt; t += 2) {
            const bool last = (t == nt - 2);
            const char* a1 = cA + (size_t)(t + 1) * kstep;
            const char* a2 = last ? nA : cA + (size_t)(t + 2) * kstep; const char* b2 = last ? nB : cB + (size_t)(t + 2) * kstep;
            const char* a3 = a2 + kstep; const char* b3 = b2 + kstep;
            PG8_LDB(B0, 0, 0); PG8_SCHED; PG8_LDA(At, 0, 0); PG8_STAGE(PG8_SA(1, 1), a1 + hstep);
            PG8_WAIT_L(8); PG8_BAR; PG8_WAIT_L(0); PG8_MMA(0, 0, At, B0); PG8_BAR; PG8_SCHED;
            PG8_LDB(B1, 0, 1); PG8_STAGE(PG8_SB(0, 0), b2);
            PG8_BAR; PG8_WAIT_L(0); PG8_MMA(0, 1, At, B1); PG8_BAR;
            PG8_LDA(At, 0, 1); PG8_STAGE(PG8_SA(0, 0), a2);
            PG8_BAR; PG8_WAIT_L(0); PG8_MMA(1, 0, At, B0); PG8_BAR; PG8_SCHED;
            PG8_STAGE(PG8_SB(0, 1), b2 + hstep);
            PG8_WAIT_V(6); PG8_BAR; PG8_MMA(1, 1, At, B1); PG8_BAR;
            PG8_LDB(B0, 1, 0); PG8_SCHED; PG8_LDA(At, 1, 0); PG8_STAGE(PG8_SA(0, 1), a2 + hstep);
            PG8_WAIT_L(8); PG8_BAR; PG8_WAIT_L(0); PG8_MMA(0, 0, At, B0); PG8_BAR; PG8_SCHED;
            PG8_LDB(B1, 1, 1); PG8_STAGE(PG8_SB(1, 0), b3);
            PG8_BAR; PG8_WAIT_L(0); PG8_MMA(0, 1, At, B1); PG8_BAR;
            PG8_LDA(At, 1, 1); PG8_STAGE(PG8_SA(1, 0), a3);
            PG8_BAR; PG8_WAIT_L(0); PG8_MMA(1, 0, At, B0); PG8_BAR; PG8_SCHED;
            PG8_STAGE(PG8_SB(1, 1), b3 + hstep);
            PG8_WAIT_V(6); PG8_BAR; PG8_MMA(1, 1, At, B1); PG8_BAR;
        }
        E(acc, cur, wr, wc, fr, fq);
        if (!has_next) break;
#pragma unroll
        for (int a = 0; a < 2; ++a)
#pragma unroll
            for (int b = 0; b < 2; ++b)
#pragma unroll
                for (int m = 0; m < 4; ++m)
#pragma unroll
                    for (int n = 0; n < 2; ++n) acc[a][b][m][n] = (f32x4){0.f, 0.f, 0.f, 0.f};
        cur = nxt; cA = nA; cB = nB; ++ui;
    }
    PG8_WAIT_V(0);
    if (wr == 0) PG8_BAR;
    PG8_BAR;
#undef PG8_SA
#undef PG8_SB
#undef PG8_STAGE
#undef PG8_LDA
#undef PG8_LDB
#undef PG8_MMA
#undef PG8_WAIT_V
#undef PG8_WAIT_L
#undef PG8_BAR
#undef PG8_SCHED
}

typedef f32x4 Acc[2][2][4][2];

template <bool FIRST> struct EpiRes {
    bf16_t* z; const float* xin; const float* cin; const float* stats; const float* lng; const float* lnb; const float* gate; bf16_t* part;
    DI void operator()(const Acc& acc, const Unit& u, int wr, int wc, int fr, int fq) const {
        const int rowb = u.pm * BM, row0 = rowb + wr * 64 + fr, col0 = u.pn * BM + wc * 32 + 8 * fq;
        if (u.ks >= 0) {
            bf16_t* pb = part + ((size_t)u.ks * TC + (row0 - TL)) * 1024 + col0;
#pragma unroll
            for (int ai = 0; ai < 2; ++ai)
#pragma unroll
                for (int m = 0; m < 4; ++m)
#pragma unroll
                    for (int bj = 0; bj < 2; ++bj) {
                        const f32x4 a = acc[ai][bj][m][0], c = acc[ai][bj][m][1];
                        u32x4 o; o[0] = pk_bf16(a[0], a[1]); o[1] = pk_bf16(a[2], a[3]); o[2] = pk_bf16(c[0], c[1]); o[3] = pk_bf16(c[2], c[3]);
                        *(u32x4*)(pb + (size_t)(ai * HALF + m * 16) * 1024 + bj * HALF) = o;
                    }
            return;
        }
        const int mi = rowb < TL ? (rowb >> 11) : 8;
        const float* gp = gate + (size_t)mi * 6144;
        f32x2 st[2][4];
        if (!FIRST) {
#pragma unroll
            for (int ai = 0; ai < 2; ++ai)
#pragma unroll
                for (int m = 0; m < 4; ++m) st[ai][m] = *(const f32x2*)(stats + 2 * (row0 + ai * HALF + m * 16));
        }
#pragma unroll
        for (int bj = 0; bj < 2; ++bj) {
            const int c = col0 + bj * HALF;
            const f32x4 gv0 = *(const f32x4*)(gp + c), gv1 = *(const f32x4*)(gp + c + 4);
            f32x4 lg0 = {0.f, 0.f, 0.f, 0.f}, lg1 = lg0, lb0 = lg0, lb1 = lg0;
            if (!FIRST) { lg0 = *(const f32x4*)(lng + c); lg1 = *(const f32x4*)(lng + c + 4); lb0 = *(const f32x4*)(lnb + c); lb1 = *(const f32x4*)(lnb + c + 4); }
#pragma unroll
            for (int ai = 0; ai < 2; ++ai) {
                u32x4 zq[4]; f32x4 xa[4], xb[4];
#pragma unroll
                for (int m = 0; m < 4; ++m) {
                    const int r = row0 + ai * HALF + m * 16;
                    if (FIRST) { const float* src = r < TL ? xin + (size_t)r * 1024 : cin + (size_t)(r - TL) * 1024; xa[m] = *(const f32x4*)(src + c); xb[m] = *(const f32x4*)(src + c + 4); }
                    else zq[m] = *(const u32x4*)(z + (size_t)r * 1024 + c);
                }
                __builtin_amdgcn_sched_barrier(0);
#pragma unroll
                for (int m = 0; m < 4; ++m) {
                    const int r = row0 + ai * HALF + m * 16;
                    f32x4 y0, y1;
                    if (FIRST) { y0 = xa[m]; y1 = xb[m]; }
                    else { const u32x2 zl = {zq[m][0], zq[m][1]}, zh = {zq[m][2], zq[m][3]};
                           y0 = (unpk4(zl) - st[ai][m][0]) * st[ai][m][1] * lg0 + lb0; y1 = (unpk4(zh) - st[ai][m][0]) * st[ai][m][1] * lg1 + lb1; }
                    y0 = y0 * ALPHA + gv0 * acc[ai][bj][m][0]; y1 = y1 * ALPHA + gv1 * acc[ai][bj][m][1];
                    u32x4 o; o[0] = pk_bf16(y0[0], y0[1]); o[1] = pk_bf16(y0[2], y0[3]); o[2] = pk_bf16(y1[0], y1[1]); o[3] = pk_bf16(y1[2], y1[3]);
                    *(u32x4*)(z + (size_t)r * 1024 + c) = o;
                }
                __builtin_amdgcn_sched_barrier(0);
            }
        }
    }
};
struct EpiMlp1 {
    bf16_t* U;
    DI void operator()(const Acc& acc, const Unit& u, int wr, int wc, int fr, int fq) const {
        const int row0 = u.pm * BM + wr * 64 + fr, col0 = u.pn * BM + wc * 64 + 8 * fq;
#pragma unroll
        for (int ai = 0; ai < 2; ++ai)
#pragma unroll
            for (int m = 0; m < 4; ++m) {
                bf16_t* rp = U + (size_t)(row0 + ai * HALF + m * 16) * 4096 + col0;
#pragma unroll
                for (int bj = 0; bj < 2; ++bj) {
                    f32x4 a = acc[ai][bj][m][0], b = acc[ai][bj][m][1];
#pragma unroll
                    for (int j = 0; j < 4; ++j) { a[j] = a[j] > 0.f ? a[j] * a[j] : 0.f; b[j] = b[j] > 0.f ? b[j] * b[j] : 0.f; }
                    u32x4 o; o[0] = pk_bf16(a[0], a[1]); o[1] = pk_bf16(a[2], a[3]); o[2] = pk_bf16(b[0], b[1]); o[3] = pk_bf16(b[2], b[3]);
                    *(u32x4*)(rp + bj * 32) = o;
                }
            }
    }
};
struct EpiQkvG {
    bf16_t* Q; bf16_t* Kd; bf16_t* Vt; const float* qn; const float* kn; const LAS float* tab;
    DI void operator()(const Acc& acc, const Unit& u, int wr, int wc, int fr, int fq) const {
        const int rowb = u.pm * BM; const bool latent = rowb < TL;
        const int b = latent ? (rowb >> 11) : ((rowb - TL) >> 8);
        const int s0 = latent ? (rowb & 2047) : 0, kp0 = latent ? 256 + s0 : 0;
        const int tile = u.pn, dbase = 32 * (fq >> 1) + 8 * (fq & 1);
        if (tile <= 4) {
            const float* gn = tile < 4 ? qn : kn;
            f32x4 g[2][2];
#pragma unroll
            for (int bj = 0; bj < 2; ++bj)
#pragma unroll
                for (int n = 0; n < 2; ++n) g[bj][n] = *(const f32x4*)(gn + dbase + 16 * bj + 4 * n);
#pragma unroll
            for (int ai = 0; ai < 2; ++ai)
#pragma unroll
                for (int m = 0; m < 4; ++m) {
                    const int rl = ai * HALF + wr * 64 + m * 16 + fr, r = rowb + rl;
                    float ss = 0.f;
#pragma unroll
                    for (int bj = 0; bj < 2; ++bj)
#pragma unroll
                        for (int n = 0; n < 2; ++n) { const f32x4 a = acc[ai][bj][m][n]; ss += a[0] * a[0] + a[1] * a[1] + a[2] * a[2] + a[3] * a[3]; }
                    ss += shx(ss, 16, 16 * fq + fr); ss += shx(ss, 32, 16 * fq + fr);
                    const float rstd = rsqrtf(ss * (1.f / 64.f) + LN_EPS);
                    f32x4 v[2][2];
#pragma unroll
                    for (int bj = 0; bj < 2; ++bj)
#pragma unroll
                        for (int n = 0; n < 2; ++n) v[bj][n] = acc[ai][bj][m][n] * rstd * g[bj][n];
                    if (latent) {
                        const int s = s0 + rl, pos = (fq >> 1) ? (s & 63) : (s >> 6);
#pragma unroll
                        for (int n = 0; n < 2; ++n) {
                            const LAS float* tp = tab + (pos * 16 + 8 * (fq & 1) + 4 * n) * 2;
                            const f32x4 t0 = *(const LAS f32x4*)tp, t1 = *(const LAS f32x4*)(tp + 4);
                            const f32x4 cs = {t0[0], t0[2], t1[0], t1[2]}, sn = {t0[1], t0[3], t1[1], t1[3]};
                            const f32x4 x1 = v[0][n], x2 = v[1][n];
                            v[0][n] = x1 * cs - x2 * sn; v[1][n] = x2 * cs + x1 * sn;
                        }
                    }
#pragma unroll
                    for (int bj = 0; bj < 2; ++bj) {
                        u32x4 o; o[0] = pk_bf16(v[bj][0][0], v[bj][0][1]); o[1] = pk_bf16(v[bj][0][2], v[bj][0][3]); o[2] = pk_bf16(v[bj][1][0], v[bj][1][1]); o[3] = pk_bf16(v[bj][1][2], v[bj][1][3]);
                        bf16_t* dst = tile < 4 ? Q + (size_t)r * 1024 + (tile * 4 + wc) * 64 + dbase + 16 * bj
                                               : Kd + ((size_t)(b * 4 + wc) * NKEY + kp0 + rl) * 64 + dbase + 16 * bj;
                        *(u32x4*)dst = o;
                    }
                }
        } else {
#pragma unroll
            for (int ai = 0; ai < 2; ++ai)
#pragma unroll
                for (int m = 0; m < 4; ++m) {
                    const int rl = ai * HALF + wr * 64 + m * 16 + fr;
                    bf16_t* vb = Vt + ((size_t)(b * 4 + wc) * NKEY + kp0 + rl) * 64 + dbase;
#pragma unroll
                    for (int bj = 0; bj < 2; ++bj) {
                        const f32x4 a = acc[ai][bj][m][0], c = acc[ai][bj][m][1];
                        u32x4 o; o[0] = pk_bf16(a[0], a[1]); o[1] = pk_bf16(a[2], a[3]); o[2] = pk_bf16(c[0], c[1]); o[3] = pk_bf16(c[2], c[3]);
                        *(u32x4*)(vb + 16 * bj) = o;
                    }
                }
        }
    }
};
struct EpiWin {
    bf16_t* cq; bf16_t* ckv; bf16_t* kpe; float* ssq; const LAS float* tab;
    DI void operator()(const Acc& acc, const Unit& u, int wr, int wc, int fr, int fq) const {
        const int rowb = u.pm * BM; const bool latent = rowb < TL;
        const int b = latent ? (rowb >> 11) : ((rowb - TL) >> 8);
        const int s0 = latent ? (rowb & 2047) : 0, kp0 = latent ? 256 + s0 : 0;
#pragma unroll
        for (int bj = 0; bj < 2; ++bj) {
            const int L = u.pn * BM + bj * HALF + wc * 32;
            if (L < 640) {
#pragma unroll
                for (int ai = 0; ai < 2; ++ai)
#pragma unroll
                    for (int m = 0; m < 4; ++m) {
                        const int r = rowb + ai * HALF + wr * 64 + m * 16 + fr;
                        const f32x4 a = acc[ai][bj][m][0], c = acc[ai][bj][m][1];
                        float ss = a[0] * a[0] + a[1] * a[1] + a[2] * a[2] + a[3] * a[3] + c[0] * c[0] + c[1] * c[1] + c[2] * c[2] + c[3] * c[3];
                        ss += shx(ss, 16, 16 * fq + fr); ss += shx(ss, 32, 16 * fq + fr);
                        if (fq == 0) ssq[(size_t)r * 20 + (L >> 5)] = ss;
                        u32x4 o; o[0] = pk_bf16(a[0], a[1]); o[1] = pk_bf16(a[2], a[3]); o[2] = pk_bf16(c[0], c[1]); o[3] = pk_bf16(c[2], c[3]);
                        bf16_t* dst = L < 384 ? cq + (size_t)r * 384 + L + 8 * fq : ckv + (size_t)r * 256 + (L - 384) + 8 * fq;
                        *(u32x4*)dst = o;
                    }
            } else if (L == 640) {
#pragma unroll
                for (int ai = 0; ai < 2; ++ai)
#pragma unroll
                    for (int m = 0; m < 4; ++m) {
                        const int rl = ai * HALF + wr * 64 + m * 16 + fr;
                        f32x4 x1 = acc[ai][bj][m][0], x2 = acc[ai][bj][m][1];
                        if (latent) {
                            const int s = s0 + rl, pos = (fq >> 1) ? (s & 63) : (s >> 6);
                            const LAS float* tp = tab + (pos * 8 + 4 * (fq & 1)) * 2;
                            const f32x4 t0 = *(const LAS f32x4*)tp, t1 = *(const LAS f32x4*)(tp + 4);
                            const f32x4 cs = {t0[0], t0[2], t1[0], t1[2]}, sn = {t0[1], t0[3], t1[1], t1[3]};
                            const f32x4 y1 = x1 * cs - x2 * sn, y2 = x2 * cs + x1 * sn; x1 = y1; x2 = y2;
                        }
                        bf16_t* dst = kpe + ((size_t)b * NKEY + kp0 + rl) * 32 + 16 * (fq >> 1) + 4 * (fq & 1);
                        u32x2 o1, o2; o1[0] = pk_bf16(x1[0], x1[1]); o1[1] = pk_bf16(x1[2], x1[3]); o2[0] = pk_bf16(x2[0], x2[1]); o2[1] = pk_bf16(x2[2], x2[3]);
                        *(u32x2*)dst = o1; *(u32x2*)(dst + 8) = o2;
                    }
            }
        }
    }
};
struct EpiUq {
    bf16_t* Q; const float* ssq; const LAS float* tab;
    DI void operator()(const Acc& acc, const Unit& u, int wr, int wc, int fr, int fq) const {
        const int rowb = u.pm * BM; const bool latent = rowb < TL;
        const int s0 = latent ? (rowb & 2047) : 0;
        float rs[2][4];
        {
            f32x4 qv[2][4];
            const int slot = fq < 3 ? fq : 0;
#pragma unroll
            for (int ai = 0; ai < 2; ++ai)
#pragma unroll
                for (int m = 0; m < 4; ++m) qv[ai][m] = *(const f32x4*)(ssq + (size_t)(rowb + ai * HALF + wr * 64 + m * 16 + fr) * 20 + slot * 4);
#pragma unroll
            for (int ai = 0; ai < 2; ++ai)
#pragma unroll
                for (int m = 0; m < 4; ++m) {
                    float t = fq < 3 ? (qv[ai][m][0] + qv[ai][m][1]) + (qv[ai][m][2] + qv[ai][m][3]) : 0.f;
                    t += shx(t, 16, 16 * fq + fr); t += shx(t, 32, 16 * fq + fr);
                    rs[ai][m] = rsqrtf(t * (1.f / 384.f) + LN_EPS);
                }
            __builtin_amdgcn_sched_barrier(0);
        }
#pragma unroll
        for (int ai = 0; ai < 2; ++ai)
#pragma unroll
            for (int m = 0; m < 4; ++m) {
                const int rl = ai * HALF + wr * 64 + m * 16 + fr, r = rowb + rl;
                const float rstd = rs[ai][m];
#pragma unroll
                for (int bj = 0; bj < 2; ++bj) {
                    const int gidx = u.pn * 8 + bj * 4 + wc, head = gidx / 3, part = gidx - head * 3;
                    f32x4 x1 = acc[ai][bj][m][0] * rstd, x2 = acc[ai][bj][m][1] * rstd;
                    bf16_t* qrow = Q + (size_t)r * 1536 + head * 96;
                    if (part < 2) {
                        u32x4 o; o[0] = pk_bf16(x1[0], x1[1]); o[1] = pk_bf16(x1[2], x1[3]); o[2] = pk_bf16(x2[0], x2[1]); o[3] = pk_bf16(x2[2], x2[3]);
                        *(u32x4*)(qrow + part * 32 + 8 * fq) = o;
                    } else {
                        if (latent) {
                            const int s = s0 + rl, pos = (fq >> 1) ? (s & 63) : (s >> 6);
                            const LAS float* tp = tab + (pos * 8 + 4 * (fq & 1)) * 2;
                            const f32x4 t0 = *(const LAS f32x4*)tp, t1 = *(const LAS f32x4*)(tp + 4);
                            const f32x4 cs = {t0[0], t0[2], t1[0], t1[2]}, sn = {t0[1], t0[3], t1[1], t1[3]};
                            const f32x4 y1 = x1 * cs - x2 * sn, y2 = x2 * cs + x1 * sn; x1 = y1; x2 = y2;
                        }
                        bf16_t* dst = qrow + 64 + 16 * (fq >> 1) + 4 * (fq & 1);
                        u32x2 o1, o2; o1[0] = pk_bf16(x1[0], x1[1]); o1[1] = pk_bf16(x1[2], x1[3]); o2[0] = pk_bf16(x2[0], x2[1]); o2[1] = pk_bf16(x2[2], x2[3]);
                        *(u32x2*)dst = o1; *(u32x2*)(dst + 8) = o2;
                    }
                }
            }
    }
};
struct EpiUkv {
    bf16_t* Kd; bf16_t* Vt; const float* ssq;
    DI void operator()(const Acc& acc, const Unit& u, int wr, int wc, int fr, int fq) const {
        const int rowb = u.pm * BM; const bool latent = rowb < TL;
        const int b = latent ? (rowb >> 11) : ((rowb - TL) >> 8);
        const int kp0 = latent ? 256 + (rowb & 2047) : 0;
        float rs[2][4];
        {
            f32x4 qv[2][4];
            const int slot = fq < 2 ? fq : 0;
#pragma unroll
            for (int ai = 0; ai < 2; ++ai)
#pragma unroll
                for (int m = 0; m < 4; ++m) qv[ai][m] = *(const f32x4*)(ssq + (size_t)(rowb + ai * HALF + wr * 64 + m * 16 + fr) * 20 + 12 + slot * 4);
#pragma unroll
            for (int ai = 0; ai < 2; ++ai)
#pragma unroll
                for (int m = 0; m < 4; ++m) {
                    float t = fq < 2 ? (qv[ai][m][0] + qv[ai][m][1]) + (qv[ai][m][2] + qv[ai][m][3]) : 0.f;
                    t += shx(t, 16, 16 * fq + fr); t += shx(t, 32, 16 * fq + fr);
                    rs[ai][m] = rsqrtf(t * (1.f / 256.f) + LN_EPS);
                }
            __builtin_amdgcn_sched_barrier(0);
        }
#pragma unroll
        for (int ai = 0; ai < 2; ++ai)
#pragma unroll
            for (int m = 0; m < 4; ++m) {
                const int rl = ai * HALF + wr * 64 + m * 16 + fr, r = rowb + rl;
                const float rstd = rs[ai][m];
#pragma unroll
                for (int bj = 0; bj < 2; ++bj) {
                    const int head = u.pn * 2 + bj;
                    const f32x4 x1 = acc[ai][bj][m][0] * rstd, x2 = acc[ai][bj][m][1] * rstd;
                    if (wc < 2) {
                        u32x4 o; o[0] = pk_bf16(x1[0], x1[1]); o[1] = pk_bf16(x1[2], x1[3]); o[2] = pk_bf16(x2[0], x2[1]); o[3] = pk_bf16(x2[2], x2[3]);
                        *(u32x4*)(Kd + ((size_t)(b * 16 + head) * NKEY + kp0 + rl) * 64 + wc * 32 + 8 * fq) = o;
                    } else {
                        u32x4 o; o[0] = pk_bf16(x1[0], x1[1]); o[1] = pk_bf16(x1[2], x1[3]); o[2] = pk_bf16(x2[0], x2[1]); o[3] = pk_bf16(x2[2], x2[3]);
                        *(u32x4*)(Vt + ((size_t)(b * 16 + head) * NKEY + kp0 + rl) * 64 + (wc - 2) * 32 + 8 * fq) = o;
                    }
                }
            }
    }
};

DI float xmax32(float x) {
    const u32x2 r = __builtin_amdgcn_permlane32_swap(__builtin_bit_cast(unsigned, x), __builtin_bit_cast(unsigned, x), false, false);
    return fmaxf(__builtin_bit_cast(float, r[0]), __builtin_bit_cast(float, r[1]));
}
DI float xsum32(float x) {
    const u32x2 r = __builtin_amdgcn_permlane32_swap(__builtin_bit_cast(unsigned, x), __builtin_bit_cast(unsigned, x), false, false);
    return __builtin_bit_cast(float, r[0]) + __builtin_bit_cast(float, r[1]);
}
template <bool MLA>
DI void attn_phase(const int TID, const int BID, LAS unsigned char* lds, const Params& p, bool need_ctx) {
    constexpr int DK = MLA ? 96 : 64;
    constexpr int NKS = DK / 16;
    constexpr int KSTR = (DK + 8) * 2;
    constexpr int VSTR = 192;
    constexpr int KBUF = 64 * KSTR, VBUF = 64 * VSTR;
    constexpr int NKV = MLA ? 16 : 4;
    constexpr int QS = 16 * DK;
    const float sc = (MLA ? 0.10206207261596575f : 0.125f) * 1.4426950408889634f;
    const int tid = TID, wid = tid >> 6, lane = tid & 63, r = lane & 31, hh = lane >> 5;
    const int n_items = 1024 + (need_ctx ? 128 : 0);
    bf16_t* O = P_WSB(OFF_H);
    for (int item = BID; item < n_items; item += gridDim.x) {
        int b, head, row0, nk;
        if (item < 1024) {
            const int rnd = item >> 8, w = item & 255, xcd = w & 7, slot = w >> 3, qb = slot & 7;
            if (MLA) { const int grp = (rnd * 8 + xcd) * 4 + (slot >> 3); b = grp >> 4; head = grp & 15; }
            else { const int grp = rnd * 8 + xcd; b = grp >> 2; head = (grp & 3) * 4 + (slot >> 3); }
            row0 = b * 2048 + qb * 256; nk = NKEY;
        }
        else { const int it = item - 1024; b = it >> 4; head = it & 15; row0 = TL + b * 256; nk = 256; }
        const int kvh = MLA ? head : (head >> 2);
        const bf16_t* Kb = P_WSB(OFF_K) + (size_t)(b * NKV + kvh) * NKEY * 64;
        const bf16_t* Vb = P_WSB(OFF_VT) + (size_t)(b * NKV + kvh) * NKEY * 64;
        const bf16_t* Pb = P_WSB(OFF_KPE) + (size_t)b * NKEY * 32;
        bf16x8 qf[NKS];
        {
            const bf16_t* qp = P_WSB(OFF_Q) + (size_t)(row0 + wid * 32 + r) * QS + head * DK + hh * 8;
#pragma unroll
            for (int ks = 0; ks < NKS; ++ks) qf[ks] = *(const bf16x8*)(qp + ks * 16);
        }
        u32x4 kreg, vreg; u32x2 preg = {0u, 0u};
#define AT_GLOADK(k0) do { kreg = *(const u32x4*)(Kb + (size_t)((k0) + (tid >> 3)) * 64 + (tid & 7) * 8); \
            if (MLA) preg = *(const u32x2*)(Pb + (size_t)((k0) + (tid >> 3)) * 32 + (tid & 7) * 4); } while (0)
#define AT_GLOADV(k0) do { vreg = *(const u32x4*)(Vb + (size_t)((k0) + (tid >> 3)) * 64 + (tid & 7) * 8); } while (0)
#define AT_WRITEK(buf) do { *(LAS u32x4*)(lds + (buf) * KBUF + (tid >> 3) * KSTR + (tid & 7) * 16) = kreg; \
            if (MLA) *(LAS u32x2*)(lds + (buf) * KBUF + (tid >> 3) * KSTR + 128 + (tid & 7) * 8) = preg; } while (0)
#define AT_WRITEV(buf) do { *(LAS u32x4*)(lds + 2 * KBUF + (buf) * VBUF + (tid >> 3) * VSTR + (tid & 7) * 16) = vreg; } while (0)
#define AT_QK(S0, S1, buf) do { const LAS unsigned char* kb = lds + (buf) * KBUF + r * KSTR + hh * 16; \
            _Pragma("unroll") for (int j = 0; j < 16; ++j) { S0[j] = 0.f; S1[j] = 0.f; } \
            _Pragma("unroll") for (int ks = 0; ks < NKS; ++ks) { \
                const bf16x8 a0 = *(const LAS bf16x8*)(kb + ks * 32); const bf16x8 a1 = *(const LAS bf16x8*)(kb + 32 * KSTR + ks * 32); \
                S0 = __builtin_amdgcn_mfma_f32_32x32x16_bf16(a0, qf[ks], S0, 0, 0, 0); S1 = __builtin_amdgcn_mfma_f32_32x32x16_bf16(a1, qf[ks], S1, 0, 0, 0); } } while (0)
#define AT_FMA(d, a_, b_, c_) do { float _a = (a_); asm("" : "+v"(_a)); d = __builtin_fmaf(_a, b_, c_); } while (0)
#define AT_ADD(d, a_, b_) do { d = (a_) + (b_); asm("" : "+v"(d)); } while (0)
#define AT_SMPV(S0, S1, buf) do { \
            float mx = fmaxf(fmaxf(S0[0], S0[1]), fmaxf(S1[0], S1[1])); \
            _Pragma("unroll") for (int j = 2; j < 16; j += 2) mx = fmaxf(mx, fmaxf(fmaxf(S0[j], S0[j + 1]), fmaxf(S1[j], S1[j + 1]))); \
            mx = xmax32(mx) * sc; \
            if (__builtin_amdgcn_ballot_w64(mx > mrun + 8.f) != 0ull) { \
                const float mnew = fmaxf(mrun, mx); const float alpha = __builtin_amdgcn_exp2f(mrun - mnew); mrun = mnew; lsum *= alpha; \
                _Pragma("unroll") for (int j = 0; j < 16; ++j) { o0[j] *= alpha; o1[j] *= alpha; } } \
            float psa = 0.f, psb = 0.f; const float nmr = -mrun; \
            _Pragma("unroll") for (int j = 0; j < 16; ++j) { \
                float e0, e1; AT_FMA(e0, S0[j], sc, nmr); AT_FMA(e1, S1[j], sc, nmr); \
                e0 = __builtin_amdgcn_exp2f(e0); e1 = __builtin_amdgcn_exp2f(e1); \
                AT_ADD(psa, psa, e0); AT_ADD(psb, psb, e1); S0[j] = e0; S1[j] = e1; } \
            lsum += psa + psb; \
            const LAS unsigned char* vb = lds + 2 * KBUF + (buf) * VBUF + (4 * hh + ((lane >> 2) & 3)) * VSTR + (16 * ((lane >> 4) & 1) + 4 * (lane & 3)) * 2; \
            _Pragma("unroll") for (int kt = 0; kt < 2; ++kt) _Pragma("unroll") for (int s = 0; s < 2; ++s) { \
                u32x4 pk; \
                if (kt == 0) { pk[0] = pk_bf16(S0[8 * s], S0[8 * s + 1]); pk[1] = pk_bf16(S0[8 * s + 2], S0[8 * s + 3]); pk[2] = pk_bf16(S0[8 * s + 4], S0[8 * s + 5]); pk[3] = pk_bf16(S0[8 * s + 6], S0[8 * s + 7]); } \
                else { pk[0] = pk_bf16(S1[8 * s], S1[8 * s + 1]); pk[1] = pk_bf16(S1[8 * s + 2], S1[8 * s + 3]); pk[2] = pk_bf16(S1[8 * s + 4], S1[8 * s + 5]); pk[3] = pk_bf16(S1[8 * s + 6], S1[8 * s + 7]); } \
                const bf16x8 pf = __builtin_bit_cast(bf16x8, pk); \
                const int koff = (kt * 32 + 16 * s) * VSTR; \
                const s16x4 l0 = __builtin_amdgcn_ds_read_tr16_b64_v4i16((LAS s16x4*)(vb + koff)), h0 = __builtin_amdgcn_ds_read_tr16_b64_v4i16((LAS s16x4*)(vb + koff + 8 * VSTR)); \
                const s16x4 l1 = __builtin_amdgcn_ds_read_tr16_b64_v4i16((LAS s16x4*)(vb + koff + 64)), h1 = __builtin_amdgcn_ds_read_tr16_b64_v4i16((LAS s16x4*)(vb + koff + 8 * VSTR + 64)); \
                const bf16x8 va0 = {l0[0], l0[1], l0[2], l0[3], h0[0], h0[1], h0[2], h0[3]}, va1 = {l1[0], l1[1], l1[2], l1[3], h1[0], h1[1], h1[2], h1[3]}; \
                o0 = __builtin_amdgcn_mfma_f32_32x32x16_bf16(va0, pf, o0, 0, 0, 0); \
                o1 = __builtin_amdgcn_mfma_f32_32x32x16_bf16(va1, pf, o1, 0, 0, 0); } } while (0)
#define AT_STEP(SC0, SC1, SN0, SN1, t, DOK, DOV) do { \
            if (DOK) AT_GLOADK(((t) + 2) * 64); \
            if (DOV) { AT_GLOADV(((t) + 1) * 64); AT_QK(SN0, SN1, ((t) + 1) & 1); } \
            AT_SMPV(SC0, SC1, (t) & 1); \
            if (DOK) AT_WRITEK((t) & 1); \
            if (DOV) AT_WRITEV(((t) + 1) & 1); \
            __syncthreads(); } while (0)
        f32x16 o0, o1, sa0, sa1, sb0, sb1;
#pragma unroll
        for (int j = 0; j < 16; ++j) { o0[j] = 0.f; o1[j] = 0.f; }
        float mrun = -1e30f, lsum = 0.f;
        if (wid >= 4) __builtin_amdgcn_s_setprio(1);
        const int ntile = nk >> 6;
        AT_GLOADK(0); AT_GLOADV(0); AT_WRITEK(0); AT_WRITEV(0);
        AT_GLOADK(64); AT_WRITEK(1);
        __syncthreads();
        AT_QK(sa0, sa1, 0);
        __syncthreads();
        int t = 0;
        for (; t < ntile - 2; t += 2) {
            AT_STEP(sa0, sa1, sb0, sb1, t, true, true);
            AT_STEP(sb0, sb1, sa0, sa1, t + 1, true, true);
        }
        AT_STEP(sa0, sa1, sb0, sb1, t, false, true);
        AT_STEP(sb0, sb1, sa0, sa1, t + 1, false, false);
        __builtin_amdgcn_s_setprio(0);
        lsum = xsum32(lsum);
        const float inv = 1.f / lsum;
        bf16_t* op = O + (size_t)(row0 + wid * 32 + r) * 1024 + head * 64 + 8 * hh;
#define AT_PK4(OX, jg) u32x2 { pk_bf16(OX[4 * (jg)] * inv, OX[4 * (jg) + 1] * inv), pk_bf16(OX[4 * (jg) + 2] * inv, OX[4 * (jg) + 3] * inv) }
#pragma unroll
        for (int k = 0; k < 2; ++k) {
            const u32x2 a = AT_PK4(o0, 2 * k), b2 = AT_PK4(o0, 2 * k + 1), c = AT_PK4(o1, 2 * k), d = AT_PK4(o1, 2 * k + 1);
            const u32x2 s0 = __builtin_amdgcn_permlane32_swap(a[0], b2[0], false, false), s1 = __builtin_amdgcn_permlane32_swap(a[1], b2[1], false, false);
            const u32x2 t0 = __builtin_amdgcn_permlane32_swap(c[0], d[0], false, false), t1 = __builtin_amdgcn_permlane32_swap(c[1], d[1], false, false);
            const u32x4 w0 = {s0[0], s1[0], s0[1], s1[1]}, w1 = {t0[0], t1[0], t0[1], t1[1]};
            *(u32x4*)(op + 16 * k) = w0; *(u32x4*)(op + 32 + 16 * k) = w1;
        }
#undef AT_PK4
#undef AT_GLOADK
#undef AT_GLOADV
#undef AT_WRITEK
#undef AT_WRITEV
#undef AT_QK
#undef AT_SMPV
#undef AT_FMA
#undef AT_ADD
#undef AT_STEP
    }
}

#define XB_TMO      128
#define XB_XCNT(j)  (256  + 64 * (j))
#define XB_XSUB(j)  (1280 + 64 * (j))
#define XB_XGEN(j)  (2304 + 64 * (j))
#define XB_TOP      3328
#define XB_TOPGEN   3392
#define XCD_BAR_WORDS 3456
#define XB_SPIN_CAP (1u << 18)
DI unsigned xb_ld(unsigned* p)              { return __hip_atomic_load(p, __ATOMIC_RELAXED, __HIP_MEMORY_SCOPE_AGENT); }
DI unsigned xb_add(unsigned* p, unsigned v) { return __hip_atomic_fetch_add(p, v, __ATOMIC_RELAXED, __HIP_MEMORY_SCOPE_AGENT); }
DI unsigned xb_xcc_id() { return (unsigned)__builtin_amdgcn_s_getreg((3 << 11) | 20) & 0xFu; }
#define XB_SPIN(cond, bar) do { unsigned _sp = 0; while (cond) { __builtin_amdgcn_s_sleep(1); \
    if ((++_sp & 255u) == 0u) { if (xb_ld(&(bar)[XB_TMO])) break; if (_sp > XB_SPIN_CAP) { atomicAdd(&(bar)[XB_TMO], 1u); break; } } } } while (0)
DI void xcd_barrier_complete(unsigned* bar, unsigned x, unsigned& nloc, unsigned& nx) {
    const unsigned G = gridDim.x;
    unsigned sum, cnt, mine, sp = 0u;
    for (;;) {
        sum = 0u; cnt = 0u; mine = 0u;
#pragma unroll
        for (unsigned j = 0; j < 16; ++j) { const unsigned c = xb_ld(&bar[XB_XCNT(j)]); sum += c; cnt += (c > 0u) ? 1u : 0u; mine = (j == x) ? c : mine; }
        if (sum == G) break;
        __builtin_amdgcn_s_sleep(1);
        if ((++sp & 255u) == 0u) { if (xb_ld(&bar[XB_TMO])) break; if (sp > XB_SPIN_CAP) { atomicAdd(&bar[XB_TMO], 1u); break; } }
    }
    nloc = mine > 0u ? mine : 1u; nx = cnt > 0u ? cnt : 1u;
}
DI void xcd_barrier(unsigned* bar, volatile LAS unsigned* st, const int tid) {
    asm volatile("s_waitcnt vmcnt(0)" ::: "memory");
    __syncthreads();
    if (tid == 0) {
        const unsigned x = xb_xcc_id();
        __builtin_amdgcn_s_waitcnt(0);
        unsigned nloc = st[0], nx = st[1];
        if (nloc == 0u) { xcd_barrier_complete(bar, x, nloc, nx); st[0] = nloc; st[1] = nx; }
        const unsigned old = xb_add(&bar[XB_XSUB(x)], 1u);
        const unsigned gen = old / nloc;
        if (old + 1u == (gen + 1u) * nloc) {
            __builtin_amdgcn_fence(__ATOMIC_RELEASE, "agent");
            asm volatile("s_waitcnt vmcnt(0)" ::: "memory");
            const unsigned og = xb_add(&bar[XB_TOP], 1u);
            const unsigned tg = og / nx;
            if (og + 1u == (tg + 1u) * nx) xb_add(&bar[XB_TOPGEN], 1u);
            else XB_SPIN(xb_ld(&bar[XB_TOPGEN]) == tg, bar);
            __builtin_amdgcn_fence(__ATOMIC_ACQUIRE, "agent");
            xb_add(&bar[XB_XGEN(x)], 1u);
            asm volatile("s_waitcnt vmcnt(0)" ::: "memory");
        } else {
            XB_SPIN(xb_ld(&bar[XB_XGEN(x)]) == gen, bar);
            __builtin_amdgcn_fence(__ATOMIC_ACQUIRE, "agent");
            asm volatile("s_waitcnt vmcnt(0)" ::: "memory");
        }
    }
    __syncthreads();
}

constexpr int NPHASE = 34;
__host__ __device__ inline bool phase_empty(int ph) { if (ph == 0 || ph == NPHASE - 1) return false; const int l = (ph - 1) >> 3, s = (ph - 1) & 7; return s == 2 && (l & 1) == 0; }

DI void run_phase(const int TID, const int BID, LAS unsigned char* lds, const Params& p, int ph) {
    if (ph == 0) { init_phase(TID, BID, lds, p); return; }
    if (ph == NPHASE - 1) { final_phase(TID, BID, p); return; }
    const int l = (ph - 1) >> 3, s = (ph - 1) & 7, j = l >> 1;
    const bool mla = l & 1;
    const int Mres = (l == 3) ? TL : TT;
    const float* modl = P_WSF(OFF_MOD) + (size_t)l * 9 * 6144;
    const LAS float* ropeG_l = (const LAS float*)(lds + LDS_ROPE);
    const LAS float* ropeM_l = (const LAS float*)(lds + LDS_ROPE + 8192);
    if (s == 1 || s == 2) {
        for (int i = TID; i < 3072; i += 512) ((LAS float*)(lds + LDS_ROPE))[i] = i < 2048 ? P_WSF(OFF_ROPEG)[i] : P_WSF(OFF_ROPEM)[i - 2048];
        __syncthreads();
    }
    switch (s) {
    case 0: prep_phase(TID, BID, p, l, 0, TT); break;
    case 1:
        if (!mla) { Gemm g{P_WSB(OFF_H), P_WSB(OFF_QKVT) + (size_t)j * 1536 * 1024, TT, 1536, 1024, 0}; EpiQkvG e{P_WSB(OFF_Q), P_WSB(OFF_K), P_WSB(OFF_VT), P_IN(11) + j * 64, P_IN(12) + j * 64, ropeG_l}; gemm_phase(TID, BID, lds, g, e); }
        else { Gemm g{P_WSB(OFF_H), P_WSB(OFF_WINT) + (size_t)j * 768 * 1024, TT, 768, 1024, 0}; EpiWin e{P_WSB(OFF_CQ), P_WSB(OFF_CKV), P_WSB(OFF_KPE), P_WSF(OFF_SSQ), ropeM_l}; gemm_phase(TID, BID, lds, g, e); }
        break;
    case 2:
        if (mla) {
            { Gemm g{P_WSB(OFF_CQ), P_WSB(OFF_WUQT) + (size_t)j * 1536 * 384, TT, 1536, 384, 0}; EpiUq e{P_WSB(OFF_Q), P_WSF(OFF_SSQ), ropeM_l}; gemm_phase(TID, BID, lds, g, e); }
            { Gemm g{P_WSB(OFF_CKV), P_WSB(OFF_WUKVT) + (size_t)j * 2048 * 256, TT, 2048, 256, 0}; EpiUkv e{P_WSB(OFF_K), P_WSB(OFF_VT), P_WSF(OFF_SSQ)}; gemm_phase(TID, BID, lds, g, e); }
        }
        break;
    case 3: if (mla) attn_phase<true>(TID, BID, lds, p, l < 3); else attn_phase<false>(TID, BID, lds, p, l < 3); break;
    case 4: {
        Gemm g{P_WSB(OFF_H), (mla ? P_WSB(OFF_WOMT) : P_WSB(OFF_WOGT)) + (size_t)j * 1024 * 1024, TL, 1024, 1024, l < 3 ? NSPLIT_WO : 0};
        if (l == 0) { EpiRes<true> e{P_WSB(OFF_Z), P_IN(0), P_IN(2), P_WSF(OFF_STATS), nullptr, nullptr, modl + 2048, P_WSB(OFF_PART)}; gemm_phase(TID, BID, lds, g, e); }
        else { EpiRes<false> e{P_WSB(OFF_Z), nullptr, nullptr, P_WSF(OFF_STATS), P_IN(6) + (l * 2 - 1) * 1024, P_IN(7) + (l * 2 - 1) * 1024, modl + 2048, P_WSB(OFF_PART)}; gemm_phase(TID, BID, lds, g, e); }
        break; }
    case 5: prep_phase(TID, BID, p, l, 1, Mres); break;
    case 6: { Gemm g{P_WSB(OFF_H), P_WSB(OFF_W1T) + (size_t)l * 4096 * 1024, Mres, 4096, 1024, 0}; EpiMlp1 e{P_WSB(OFF_U)}; gemm_phase(TID, BID, lds, g, e); break; }
    case 7: { Gemm g{P_WSB(OFF_U), P_WSB(OFF_W2T) + (size_t)l * 1024 * 4096, TL, 1024, 4096, l < 3 ? NSPLIT_M2 : 0}; EpiRes<false> e{P_WSB(OFF_Z), nullptr, nullptr, P_WSF(OFF_STATS), P_IN(6) + (l * 2) * 1024, P_IN(7) + (l * 2) * 1024, modl + 5120, P_WSB(OFF_PART)}; gemm_phase(TID, BID, lds, g, e); break; }
    }
}

__global__ void __launch_bounds__(512) mega(Params p, int ph_lo, int ph_hi) {
    extern __shared__ __attribute__((aligned(16))) unsigned char shm[];
    cg::grid_group grid = cg::this_grid();
    volatile LAS unsigned* st = (volatile LAS unsigned*)((LAS unsigned char*)shm + LDS_STAGE);
    unsigned* bar = (unsigned*)(GAS unsigned*)(p.ws + OFF_BAR);
    if (threadIdx.x == 0) { st[0] = 0u; st[1] = 0u; (void)xb_add(&bar[XB_XCNT(xb_xcc_id())], 1u); }
    __syncthreads();
    if (ph_lo < -1000) grid.sync();
    bool first = true, dup = false;
    for (int ph = ph_lo; ph < ph_hi; ++ph) {
        if (phase_empty(ph)) continue;
        int tid = threadIdx.x, bid = blockIdx.x; unsigned lbase = 0;
        asm volatile("" : "+v"(tid), "+s"(bid), "+s"(lbase));
        if (!first) xcd_barrier(bar, st, tid);
        first = false;
        run_phase(tid, bid, (LAS unsigned char*)shm + lbase, p, ph);
#ifdef PROBE_DUP
        if ((ph == 0 ? ((PROBE_DUP >> 8) & 1) : (ph < NPHASE - 1 && ((PROBE_DUP >> ((ph - 1) & 7)) & 1))) && !dup) { dup = true; --ph; } else dup = false;
#endif
    }
}

extern "C" void kernel_launch(void* const* d_in, const int* in_sizes, int n_in, void* d_out, int out_size, void* d_ws, size_t ws_size, hipStream_t stream) {
    static int grid_blocks = 0;
    if (!grid_blocks) {
        int dev = 0, cus = 0, per_cu = 0;
        hipGetDevice(&dev);
        hipDeviceGetAttribute(&cus, hipDeviceAttributeMultiprocessorCount, dev);
        hipFuncSetAttribute((const void*)mega, hipFuncAttributeMaxDynamicSharedMemorySize, LDS_BYTES);
        hipOccupancyMaxActiveBlocksPerMultiprocessor(&per_cu, mega, 512, LDS_BYTES);
        if (per_cu < 1) per_cu = 1;
        grid_blocks = cus * per_cu;
    }
    Params p{};
    for (int i = 0; i < 20; ++i) p.in[i] = (const float*)d_in[i];
    p.out = (float*)d_out; p.ws = (unsigned char*)d_ws;
    if (WS_NEED > ws_size) { fprintf(stderr, "workspace too small: need %zu have %zu\n", (size_t)WS_NEED, ws_size); return; }
    hipMemsetAsync(d_ws, 0, BAR_BYTES, stream);
#if MK_SINGLE
    int lo = 0, hi = NPHASE;
    void* args[] = {&p, &lo, &hi};
    hipError_t e = hipLaunchCooperativeKernel((const void*)mega, dim3(grid_blocks), dim3(512), args, LDS_BYTES, stream);
    if (e != hipSuccess) fprintf(stderr, "cooperative launch failed: %s (grid %d)\n", hipGetErrorString(e), grid_blocks);
#else
    for (int ph = 0; ph < NPHASE; ++ph) {
        if (phase_empty(ph)) continue;
        mega<<<dim3(grid_blocks), dim3(512), LDS_BYTES, stream>>>(p, ph, ph + 1);
    }
#endif
}
```
